# Optimizing an MI355X kernel written in HIP

```python
import jax, jax.numpy as jnp
from jax import lax
import numpy as np

D_MODEL = 1024
BATCH = 8
SEQ = 4096
DEPTH = 1
DEC_BATCH = 1
DEC_SEQ = 16384
PAST_LEN = 128

GRID_W = 64
GLA_HEADS = 4
GLA_DK = 64
GLA_DV = 128
GLA_LOWRANK = 16
GLA_TAU = 16.0
GLA_CHUNK = 64
NA_HEADS = 8
NA_DH = 64
NA_WIN_R = 8
NA_WIN_C = 16
NA_QBLOCK_C = 16
NA_BAND_C = 32
MIX_W = GLA_HEADS * GLA_DV + NA_HEADS * NA_DH
D_FF = 2816
CONV_W = 3
LN_EPS = 1e-5
RMS_EPS = 1e-6
DEEPNORM_ALPHA = (2.0 * DEPTH) ** 0.25
DEEPNORM_BETA = (8.0 * DEPTH) ** -0.25
IN_SIZES = (GLA_HEADS * GLA_DK, GLA_HEADS * GLA_DK, GLA_HEADS * GLA_DV, GLA_HEADS * GLA_DV,
            2 * GLA_LOWRANK, NA_HEADS * NA_DH, NA_HEADS * NA_DH, NA_HEADS * NA_DH)
IN_W = sum(IN_SIZES)

kernel_name = 'hymba_gla_natten_deepnorm_encoder'


def _split_points(sizes):
    pts, acc = [], 0
    for s in sizes[:-1]:
        acc += s
        pts.append(acc)
    return pts


def layer_norm(x, g, b):
    xf = x.astype(jnp.float32)
    mu = jnp.mean(xf, axis=-1, keepdims=True)
    var = jnp.mean(jnp.square(xf - mu), axis=-1, keepdims=True)
    y = (xf - mu) * lax.rsqrt(var + LN_EPS) * g.astype(jnp.float32) + b.astype(jnp.float32)
    return y.astype(x.dtype)


def to_heads(t, n_heads):
    B, T, _ = t.shape
    return t.reshape(B, T, n_heads, -1).transpose(0, 2, 1, 3)


def gla_chunked(q, k, v, log_a):
    B, H, T, dk = q.shape
    dv = v.shape[-1]
    n = T // GLA_CHUNK
    q = q.reshape(B, H, n, GLA_CHUNK, dk)
    k = k.reshape(B, H, n, GLA_CHUNK, dk)
    v = v.reshape(B, H, n, GLA_CHUNK, dv)
    b = jnp.cumsum(log_a.reshape(B, H, n, GLA_CHUNK, dk), axis=3)
    b_last = b[:, :, :, -1:, :]
    q_in = q * jnp.exp(b)
    k_in = k * jnp.exp(-b)
    k_end = k * jnp.exp(b_last - b)
    lower = jnp.tril(jnp.ones((GLA_CHUNK, GLA_CHUNK), dtype=bool))
    a = jnp.where(lower, jnp.einsum('bhnid,bhnjd->bhnij', q_in, k_in), 0.0)
    o_intra = jnp.einsum('bhnij,bhnjv->bhniv', a, v)
    u = jnp.einsum('bhnjd,bhnjv->nbhdv', k_end, v)
    decay = jnp.exp(b_last[:, :, :, 0, :]).transpose(2, 0, 1, 3)

    def step(s, inp):
        d_c, u_c = inp
        return d_c[..., None] * s + u_c, s

    _, s_prev = lax.scan(step, jnp.zeros((B, H, dk, dv), q.dtype), (decay, u))
    o_inter = jnp.einsum('bhnid,nbhdv->bhniv', q_in, s_prev)
    return (o_intra + o_inter).reshape(B, H, T, dv)


def gla_mixer(q, k, v, g, lr, w_gate_fwd, b_gate_fwd, w_gate_bwd, b_gate_bwd, norm_g):
    dtype = q.dtype
    lr_f, lr_b = jnp.split(lr, 2, axis=-1)
    la_f = jax.nn.log_sigmoid((lr_f @ w_gate_fwd + b_gate_fwd).astype(jnp.float32)) / GLA_TAU
    la_b = jax.nn.log_sigmoid((lr_b @ w_gate_bwd + b_gate_bwd).astype(jnp.float32)) / GLA_TAU
    qh = to_heads(q, GLA_HEADS).astype(jnp.float32) * (GLA_DK ** -0.5)
    kh = to_heads(k, GLA_HEADS).astype(jnp.float32)
    vh = to_heads(v, GLA_HEADS).astype(jnp.float32)
    la_f = to_heads(la_f, GLA_HEADS)
    la_b = to_heads(la_b, GLA_HEADS)
    flip = lambda t: jnp.flip(t, axis=2)
    o = gla_chunked(qh, kh, vh, la_f) + flip(gla_chunked(flip(qh), flip(kh), flip(vh), flip(la_b)))
    o = o * lax.rsqrt(jnp.mean(jnp.square(o), axis=-1, keepdims=True) + RMS_EPS) * norm_g.astype(jnp.float32)
    B, H, T, dv = o.shape
    o = o.transpose(0, 2, 1, 3).reshape(B, T, H * dv).astype(dtype)
    return o * jax.nn.silu(g)


def neighbourhood_attention(q, k, v, rpb):
    B, T, _ = q.shape
    rows = T // GRID_W
    kr = min(NA_WIN_R, rows)
    ncb = GRID_W // NA_QBLOCK_C
    r = jnp.arange(rows)
    row_start = jnp.clip(r - kr // 2, 0, rows - kr)
    key_rows = row_start[:, None] + jnp.arange(kr)[None, :]
    qcols = jnp.arange(GRID_W).reshape(ncb, NA_QBLOCK_C)
    q_col_start = jnp.clip(qcols - NA_WIN_C // 2, 0, GRID_W - NA_WIN_C)
    band_start = jnp.clip(jnp.arange(ncb) * NA_QBLOCK_C - NA_WIN_C // 2, 0, GRID_W - NA_BAND_C)
    band_cols = band_start[:, None] + jnp.arange(NA_BAND_C)[None, :]
    col_in = ((band_cols[:, None, :] >= q_col_start[..., None]) &
              (band_cols[:, None, :] < q_col_start[..., None] + NA_WIN_C))
    dr = key_rows - r[:, None]
    dc = jnp.clip(band_cols[:, None, :] - qcols[..., None], -(NA_WIN_C - 1), NA_WIN_C - 1)
    bias = rpb[:, (dr + NA_WIN_R - 1)[:, None, None, :, None],
               (dc + NA_WIN_C - 1)[None, :, :, None, :]]
    qh = to_heads(q, NA_HEADS).reshape(B, NA_HEADS, rows, ncb, NA_QBLOCK_C, NA_DH)
    kh = to_heads(k, NA_HEADS).reshape(B, NA_HEADS, rows, GRID_W, NA_DH)
    vh = to_heads(v, NA_HEADS).reshape(B, NA_HEADS, rows, GRID_W, NA_DH)
    ri = key_rows[:, None, :, None]
    ci = band_cols[None, :, None, :]
    kg = kh[:, :, ri, ci]
    vg = vh[:, :, ri, ci]
    s = jnp.einsum('bhrnqd,bhrnkcd->bhrnqkc', qh, kg).astype(jnp.float32) * (NA_DH ** -0.5)
    s = s + bias.astype(jnp.float32)[None]
    s = jnp.where(col_in[None, None, None, :, :, None, :], s, -jnp.inf)
    p = jax.nn.softmax(s, axis=(-2, -1))
    o = jnp.einsum('bhrnqkc,bhrnkcd->bhrnqd', p.astype(v.dtype), vg)
    return o.reshape(B, NA_HEADS, T, NA_DH).transpose(0, 2, 1, 3).reshape(B, T, NA_HEADS * NA_DH)


def conv_gated_mlp(x, w_up, conv_w, conv_b, w_down):
    h = x @ w_up
    zero = jnp.zeros_like(h[:, :1])
    h_prev = jnp.concatenate([zero, h[:, :-1]], axis=1)
    h_next = jnp.concatenate([h[:, 1:], zero], axis=1)
    h = h_prev * conv_w[0] + h * conv_w[1] + h_next * conv_w[2] + conv_b
    a, gate = jnp.split(h, 2, axis=-1)
    return (jax.nn.silu(gate) * a) @ w_down


def encoder_trunk(x, ln_in_g, ln_in_b, w_in, gla_gate_w_fwd, gla_gate_b_fwd, gla_gate_w_bwd,
                  gla_gate_b_bwd, gla_norm_g, na_rpb, w_out, ln1_g, ln1_b, w_up, conv_w, conv_b,
                  w_down, ln2_g, ln2_b):
    x = layer_norm(x, ln_in_g, ln_in_b)
    pts = _split_points(IN_SIZES)
    for l in range(DEPTH):
        proj = x @ w_in[l]
        gq, gk, gv, gg, glr, nq, nk, nv = jnp.split(proj, pts, axis=-1)
        o_gla = gla_mixer(gq, gk, gv, gg, glr, gla_gate_w_fwd[l], gla_gate_b_fwd[l],
                          gla_gate_w_bwd[l], gla_gate_b_bwd[l], gla_norm_g[l])
        o_na = neighbourhood_attention(nq, nk, nv, na_rpb[l])
        mix = jnp.concatenate([o_gla, o_na], axis=-1) @ w_out[l]
        x = layer_norm(DEEPNORM_ALPHA * x + mix, ln1_g[l], ln1_b[l])
        f = conv_gated_mlp(x, w_up[l], conv_w[l], conv_b[l], w_down[l])
        x = layer_norm(DEEPNORM_ALPHA * x + f, ln2_g[l], ln2_b[l])
    return x


def setup_inputs(seed: int = 0) -> dict:
    key = jax.random.key(seed)
    ks = jax.random.split(key, 24)
    nrm = lambda k, shape, scale: jax.random.normal(k, shape, jnp.float32) * scale
    gain = lambda k, shape: 1.0 + 0.02 * jax.random.normal(k, shape, jnp.float32)
    return {
        'x_prompt': nrm(ks[0], (BATCH, SEQ, D_MODEL), 1.0),
        'x_sample': nrm(ks[1], (DEC_BATCH, DEC_SEQ, D_MODEL), 1.0),
        'ln_in_g': gain(ks[2], (D_MODEL,)),
        'ln_in_b': nrm(ks[3], (D_MODEL,), 0.02),
        'w_in': nrm(ks[4], (DEPTH, D_MODEL, IN_W), D_MODEL ** -0.5),
        'gla_gate_w_fwd': nrm(ks[5], (DEPTH, GLA_LOWRANK, GLA_HEADS * GLA_DK), GLA_LOWRANK ** -0.5),
        'gla_gate_b_fwd': nrm(ks[6], (DEPTH, GLA_HEADS * GLA_DK), 0.1),
        'gla_gate_w_bwd': nrm(ks[7], (DEPTH, GLA_LOWRANK, GLA_HEADS * GLA_DK), GLA_LOWRANK ** -0.5),
        'gla_gate_b_bwd': nrm(ks[8], (DEPTH, GLA_HEADS * GLA_DK), 0.1),
        'gla_norm_g': gain(ks[9], (DEPTH, GLA_DV)),
        'na_rpb': nrm(ks[10], (DEPTH, NA_HEADS, 2 * NA_WIN_R - 1, 2 * NA_WIN_C - 1), 0.1),
        'w_out': nrm(ks[11], (DEPTH, MIX_W, D_MODEL), DEEPNORM_BETA * MIX_W ** -0.5),
        'ln1_g': gain(ks[12], (DEPTH, D_MODEL)),
        'ln1_b': nrm(ks[13], (DEPTH, D_MODEL), 0.02),
        'w_up': nrm(ks[14], (DEPTH, D_MODEL, 2 * D_FF), D_MODEL ** -0.5),
        'conv_w': nrm(ks[15], (DEPTH, CONV_W, 2 * D_FF), CONV_W ** -0.5),
        'conv_b': nrm(ks[16], (DEPTH, 2 * D_FF), 0.02),
        'w_down': nrm(ks[17], (DEPTH, D_FF, D_MODEL), DEEPNORM_BETA * D_FF ** -0.5),
        'ln2_g': gain(ks[18], (DEPTH, D_MODEL)),
        'ln2_b': nrm(ks[19], (DEPTH, D_MODEL), 0.02),
    }


def reference(x_prompt, x_sample, ln_in_g, ln_in_b, w_in, gla_gate_w_fwd, gla_gate_b_fwd,
              gla_gate_w_bwd, gla_gate_b_bwd, gla_norm_g, na_rpb, w_out, ln1_g, ln1_b, w_up,
              conv_w, conv_b, w_down, ln2_g, ln2_b):
    y_prompt = encoder_trunk(x_prompt, ln_in_g, ln_in_b, w_in, gla_gate_w_fwd, gla_gate_b_fwd,
                             gla_gate_w_bwd, gla_gate_b_bwd, gla_norm_g, na_rpb, w_out, ln1_g,
                             ln1_b, w_up, conv_w, conv_b, w_down, ln2_g, ln2_b)
    y_sample = encoder_trunk(x_sample, ln_in_g, ln_in_b, w_in, gla_gate_w_fwd, gla_gate_b_fwd,
                             gla_gate_w_bwd, gla_gate_b_bwd, gla_norm_g, na_rpb, w_out, ln1_g,
                             ln1_b, w_up, conv_w, conv_b, w_down, ln2_g, ln2_b)
    return (y_prompt, y_sample)
```

```cpp
#include <hip/hip_runtime.h>
#include <hip/hip_cooperative_groups.h>
#include <cstdio>
#include <cstdint>
namespace cg = cooperative_groups;
#ifndef MK_N_LAUNCHES
#define MK_N_LAUNCHES 1
#endif
#ifndef DBG_STOP
#define DBG_STOP 11
#endif
namespace pg8 {
#define PG8_LAS __attribute__((address_space(3)))
typedef unsigned short bf16_t;
typedef short bf16x8 __attribute__((ext_vector_type(8)));
typedef float f32x4 __attribute__((ext_vector_type(4)));
typedef unsigned u32x4 __attribute__((ext_vector_type(4)));
constexpr int BM = 256, BK = 64, HALF = 128, HTB = HALF * BK * 2  , STAGE_BYTES = 8 * HTB, NXCD = 8, WGM = 8;

__host__ __device__ __forceinline__ int lds_byte(int r, int c) { const int st = (r >> 4) * 2 + (c >> 5), rr = r & 15, cc = c & 31, ob = rr * 64 + cc * 2; return st * 1024 + (ob ^ (((ob >> 9) & 1) << 5)); }
__host__ __device__ __forceinline__ void stage_rc(int b, int& R, int& C) { const int st = b / 1024, sb = b % 1024, swz = sb ^ (((sb >> 9) & 1) << 5); R = (st >> 1) * 16 + swz / 64; C = (st & 1) * 32 + (swz % 64) / 2; }
__host__ __device__ __forceinline__ int perm32(int rho) { const int n = rho >> 4, i = rho & 15; return 8 * (i >> 2) + 4 * n + (i & 3); }

struct Unit { int pm, pn; };
struct Gemm { const bf16_t* A; const bf16_t* Bt; int M, N, K; };

struct StaticOrder {
    int nM, nN, nwg, G, c;
    __host__ __device__ void init(int M, int N, int G_, int c_) { nM = M / BM; nN = N / BM; nwg = nM * nN; G = G_; c = c_; }
    __host__ __device__ bool next(int i, Unit& u) const {
        const long L = (long)i * G + c; if (L >= nwg) return false;
        int wgid = (int)L; { const int q = nwg / NXCD, r = nwg % NXCD, xcd = wgid % NXCD, off = wgid / NXCD; wgid = (xcd < r ? xcd * (q + 1) : r * (q + 1) + (xcd - r) * q) + off; }
        const int nig = WGM * nN, gid = wgid / nig, fm = gid * WGM, gsz = (nM - fm) < WGM ? (nM - fm) : WGM;
        u.pm = fm + ((wgid % nig) % gsz); u.pn = (wgid % nig) / gsz; return true;
    }
    __device__ __forceinline__ void a_ready(const Unit&) const {}
    __device__ __forceinline__ void done(const Unit&) const {}
};

__device__ __forceinline__ unsigned cvt_pk_bf16(float lo, float hi) { unsigned r; asm volatile("v_cvt_pk_bf16_f32 %0, %1, %2" : "=v"(r) : "v"(lo), "v"(hi)); return r; }
template <class Epi, class Sched, bool ALIGN_EPI = false, bool SP2 = false>
__device__ __forceinline__ void gemm_phase(PG8_LAS unsigned char* lds, const Gemm g, const Sched& S, const Epi& E) {
    const int tid = threadIdx.x, wid = __builtin_amdgcn_readfirstlane(tid >> 6), lane = tid & 63, wr = wid >> 2, wc = wid & 3, fr = lane & 15, fq = lane >> 4;
    const int K = g.K, nt = K / BK;
    unsigned voffA[2], voffB[2];
#pragma unroll
    for (int i = 0; i < 2; ++i) { int R, C; stage_rc(tid * 16 + i * 8192, R, C); const int Rb = Epi::PERM ? ((R & ~31) + perm32(R & 31)) : R;
        voffA[i] = (unsigned)(R * K + C) * 2u; voffB[i] = (unsigned)(Rb * K + C) * 2u; }
    const size_t kstep = (size_t)(BK * 2);
    const size_t hstep = (size_t)HALF * K * 2;
    const size_t tstep = 2 * hstep;
    const unsigned ldsw = (unsigned)wid * 1024u;
    const int aoff = lds_byte(wr * 64 + fr, fq * 8), boff = lds_byte(wc * 32 + fr, fq * 8);
#define PG8_SA(b, h) (((b) * 2 + (h)) * HTB)
#define PG8_SB(b, h) ((4 + (b) * 2 + (h)) * HTB)
#define PG8_STAGE(bufoff, gbase, voff) do { _Pragma("unroll") for (int _i = 0; _i < 2; ++_i) \
        __builtin_amdgcn_global_load_lds((const unsigned*)((const char*)(gbase) + (voff)[_i]), (PG8_LAS unsigned*)(lds + (bufoff) + ldsw + _i * 8192), 16, 0, 0); } while (0)
#define PG8_LDA(dst, b, h) do { _Pragma("unroll") for (int m = 0; m < 4; ++m) _Pragma("unroll") for (int k = 0; k < 2; ++k) dst[m][k] = *(const PG8_LAS bf16x8*)(lds + PG8_SA(b, h) + aoff + m * 2048 + k * 1024); } while (0)
#define PG8_LDB(dst, b, h) do { _Pragma("unroll") for (int n = 0; n < 2; ++n) _Pragma("unroll") for (int k = 0; k < 2; ++k) dst[n][k] = *(const PG8_LAS bf16x8*)(lds + PG8_SB(b, h) + boff + n * 2048 + k * 1024); } while (0)
#define PG8_MMA(ai, bj, At, Bt) do { __builtin_amdgcn_s_setprio(1); _Pragma("unroll") for (int m = 0; m < 4; ++m) _Pragma("unroll") for (int n = 0; n < 2; ++n) _Pragma("unroll") for (int k = 0; k < 2; ++k) \
        acc[ai][bj][m][n] = __builtin_amdgcn_mfma_f32_16x16x32_bf16(Bt[n][k], At[m][k], acc[ai][bj][m][n], 0, 0, 0); __builtin_amdgcn_s_setprio(0); } while (0)
#define PG8_WAIT_V(n) asm volatile("s_waitcnt vmcnt(" #n ")" ::: "memory")
#define PG8_WAIT_L(n) asm volatile("s_waitcnt lgkmcnt(" #n ")" ::: "memory")
#define PG8_BAR __builtin_amdgcn_s_barrier()
#define PG8_SCHED __builtin_amdgcn_sched_barrier(0)
    Unit cur, nxt; int ui = 0;
    if (!S.next(0, cur)) return;
    f32x4 acc[2][2][4][2];
#pragma unroll
    for (int a = 0; a < 2; ++a)
#pragma unroll
        for (int b = 0; b < 2; ++b)
#pragma unroll
            for (int m = 0; m < 4; ++m)
#pragma unroll
                for (int n = 0; n < 2; ++n) acc[a][b][m][n] = (f32x4){0.f, 0.f, 0.f, 0.f};
    bf16x8 At[4][2], B0[2][2], B1[2][2];
    const char* cA = (const char*)g.A + (size_t)cur.pm * tstep; const char* cB = (const char*)g.Bt + (size_t)cur.pn * tstep;
    S.a_ready(cur);
    if constexpr (SP2) {
        PG8_STAGE(PG8_SB(0, 0), cB, voffB); PG8_STAGE(PG8_SB(0, 1), cB + hstep, voffB); PG8_STAGE(PG8_SA(0, 0), cA, voffA); PG8_STAGE(PG8_SA(0, 1), cA + hstep, voffA);
        if (wr == 1) PG8_BAR;
        PG8_WAIT_V(2); PG8_BAR;
        PG8_STAGE(PG8_SB(1, 0), cB + kstep, voffB); PG8_STAGE(PG8_SA(1, 0), cA + kstep, voffA); PG8_STAGE(PG8_SB(1, 1), cB + hstep + kstep, voffB);
        PG8_WAIT_V(6); PG8_BAR;
    } else {
        PG8_STAGE(PG8_SB(0, 0), cB, voffB); PG8_STAGE(PG8_SA(0, 0), cA, voffA); PG8_STAGE(PG8_SB(0, 1), cB + hstep, voffB); PG8_STAGE(PG8_SA(0, 1), cA + hstep, voffA);
        if (wr == 1) PG8_BAR;
        PG8_WAIT_V(4); PG8_BAR;
        PG8_STAGE(PG8_SB(1, 0), cB + kstep, voffB); PG8_STAGE(PG8_SA(1, 0), cA + kstep, voffA); PG8_STAGE(PG8_SB(1, 1), cB + hstep + kstep, voffB);
        PG8_WAIT_V(6); PG8_BAR;
    }
    for (;;) {
        const bool has_next = S.next(ui + 1, nxt);
        const char* nA = has_next ? (const char*)g.A + (size_t)nxt.pm * tstep : cA; const char* nB = has_next ? (const char*)g.Bt + (size_t)nxt.pn * tstep : cB;
        for (int t = 0; t < nt; t += 2) {
            const bool last = (t == nt - 2);
            const char* a1 = cA + (size_t)(t + 1) * kstep;
            const char* a2 = last ? nA : cA + (size_t)(t + 2) * kstep; const char* b2 = last ? nB : cB + (size_t)(t + 2) * kstep;
            const char* a3 = a2 + kstep; const char* b3 = b2 + kstep;
            if (last && has_next) S.a_ready(nxt);
            if constexpr (SP2) {
            PG8_LDB(B0, 0, 0); PG8_LDB(B1, 0, 1); PG8_SCHED; PG8_LDA(At, 0, 0); PG8_STAGE(PG8_SA(1, 1), a1 + hstep, voffA);
            PG8_WAIT_V(8); PG8_WAIT_L(0); PG8_BAR; PG8_MMA(0, 0, At, B0); PG8_MMA(0, 1, At, B1); PG8_BAR; PG8_SCHED;
            PG8_LDA(At, 0, 1); PG8_STAGE(PG8_SB(0, 0), b2, voffB); PG8_STAGE(PG8_SB(0, 1), b2 + hstep, voffB); PG8_STAGE(PG8_SA(0, 0), a2, voffA);
            PG8_WAIT_V(8); PG8_WAIT_L(0); PG8_BAR; PG8_MMA(1, 0, At, B0); PG8_MMA(1, 1, At, B1); PG8_BAR; PG8_SCHED;
            PG8_LDB(B0, 1, 0); PG8_LDB(B1, 1, 1); PG8_SCHED; PG8_LDA(At, 1, 0); PG8_STAGE(PG8_SA(0, 1), a2 + hstep, voffA);
            PG8_WAIT_V(8); PG8_WAIT_L(0); PG8_BAR; PG8_MMA(0, 0, At, B0); PG8_MMA(0, 1, At, B1); PG8_BAR; PG8_SCHED;
            PG8_LDA(At, 1, 1); PG8_STAGE(PG8_SB(1, 0), b3, voffB); PG8_STAGE(PG8_SB(1, 1), b3 + hstep, voffB); PG8_STAGE(PG8_SA(1, 0), a3, voffA);
            PG8_WAIT_V(8); PG8_WAIT_L(0); PG8_BAR; PG8_MMA(1, 0, At, B0); PG8_MMA(1, 1, At, B1); PG8_BAR; PG8_SCHED;
            } else {
            PG8_LDB(B0, 0, 0); PG8_SCHED; PG8_LDA(At, 0, 0); PG8_STAGE(PG8_SA(1, 1), a1 + hstep, voffA);
            PG8_WAIT_L(8); PG8_BAR; PG8_WAIT_L(0); PG8_MMA(0, 0, At, B0); PG8_BAR; PG8_SCHED;
            PG8_LDB(B1, 0, 1); PG8_STAGE(PG8_SB(0, 0), b2, voffB);
            PG8_BAR; PG8_WAIT_L(0); PG8_MMA(0, 1, At, B1); PG8_BAR;
            PG8_LDA(At, 0, 1); PG8_STAGE(PG8_SA(0, 0), a2, voffA);
            PG8_BAR; PG8_WAIT_L(0); PG8_MMA(1, 0, At, B0); PG8_BAR; PG8_SCHED;
            PG8_STAGE(PG8_SB(0, 1), b2 + hstep, voffB);
            PG8_WAIT_V(6); PG8_BAR; PG8_MMA(1, 1, At, B1); PG8_BAR;
            PG8_LDB(B0, 1, 0); PG8_SCHED; PG8_LDA(At, 1, 0); PG8_STAGE(PG8_SA(0, 1), a2 + hstep, voffA);
            PG8_WAIT_L(8); PG8_BAR; PG8_WAIT_L(0); PG8_MMA(0, 0, At, B0); PG8_BAR; PG8_SCHED;
            PG8_LDB(B1, 1, 1); PG8_STAGE(PG8_SB(1, 0), b3, voffB);
            PG8_BAR; PG8_WAIT_L(0); PG8_MMA(0, 1, At, B1); PG8_BAR;
            PG8_LDA(At, 1, 1); PG8_STAGE(PG8_SA(1, 0), a3, voffA);
            PG8_BAR; PG8_WAIT_L(0); PG8_MMA(1, 0, At, B0); PG8_BAR; PG8_SCHED;
            PG8_STAGE(PG8_SB(1, 1), b3 + hstep, voffB);
            PG8_WAIT_V(6); PG8_BAR; PG8_MMA(1, 1, At, B1); PG8_BAR;
            }
        }
        if constexpr (ALIGN_EPI) { if (wr == 0) PG8_BAR; }
        if constexpr (!Epi::AFTER_DRAIN) { E(acc, cur, wr, wc, fr, fq); S.done(cur); }
        if (!has_next) break;
#pragma unroll
        for (int a = 0; a < 2; ++a)
#pragma unroll
            for (int b = 0; b < 2; ++b)
#pragma unroll
                for (int m = 0; m < 4; ++m)
#pragma unroll
                    for (int n = 0; n < 2; ++n) acc[a][b][m][n] = (f32x4){0.f, 0.f, 0.f, 0.f};
        cur = nxt; cA = nA; cB = nB; ++ui;
        if constexpr (ALIGN_EPI) { if (wr == 1) PG8_BAR; }
    }
    PG8_WAIT_V(0);
    if constexpr (!ALIGN_EPI) { if (wr == 0) PG8_BAR; }
    PG8_BAR;
    if constexpr (Epi::AFTER_DRAIN) { E.fused(acc, cur, wr, wc, fr, fq, lds, wid, lane); S.done(cur); }
#undef PG8_SA
#undef PG8_SB
#undef PG8_STAGE
#undef PG8_LDA
#undef PG8_LDB
#undef PG8_MMA
#undef PG8_WAIT_V
#undef PG8_WAIT_L
#undef PG8_BAR
#undef PG8_SCHED
}
}


#define LAS __attribute__((address_space(3)))
typedef unsigned short bf16;
typedef float f32x4 __attribute__((ext_vector_type(4)));
typedef float f32x2 __attribute__((ext_vector_type(2)));
typedef short bf16x8 __attribute__((ext_vector_type(8)));
typedef short s16x4 __attribute__((ext_vector_type(4)));
typedef unsigned u32x4 __attribute__((ext_vector_type(4)));
typedef unsigned u32x2 __attribute__((ext_vector_type(2)));

constexpr int NWAVES = 8, NTHR = 512;
constexpr int T = 49152, DM = 1024, TP = 32768;
constexpr int NIN = 3328;
constexpr int FF = 2816, FF2 = 5632;
constexpr int NCH = T / 64;
constexpr float ALPHA = 1.189207115002721f;
constexpr float LN_EPS = 1e-5f, RMS_EPS = 1e-6f;
constexpr size_t MiB = 1u << 20;
constexpr size_t WS_WIN = 1 * MiB, WS_WOUT = 8 * MiB, WS_WUP = 10 * MiB, WS_WDN = 21 * MiB, WS_XN = 27 * MiB, WS_C = 123 * MiB;
constexpr size_t WS_GQ = WS_C, WS_GK = WS_C + 24 * MiB, WS_GV = WS_C + 48 * MiB, WS_GG = WS_C + 96 * MiB, WS_NQ = WS_C + 144 * MiB, WS_NK = WS_C + 192 * MiB,
                 WS_NVT = WS_C + 240 * MiB, WS_LR = WS_C + 288 * MiB, WS_DEC = WS_C + 294 * MiB;
constexpr size_t WS_Y1 = WS_C, WS_ACT = WS_C, WS_HRAW = WS_C + 264 * MiB, WS_END = WS_C + 297 * MiB;
constexpr size_t OUT_MIX = 0, OUT_US = 96 * MiB;
constexpr int LDS_BYTES = 147456;
constexpr int LP = 72;

__device__ __forceinline__ float bf2f(unsigned short b) { return __builtin_bit_cast(float, (unsigned)b << 16); }
__device__ __forceinline__ float bflo(unsigned w) { return __builtin_bit_cast(float, w << 16); }
__device__ __forceinline__ float bfhi(unsigned w) { return __builtin_bit_cast(float, w & 0xffff0000u); }
typedef __bf16 bf16x2_t __attribute__((ext_vector_type(2)));
__device__ __forceinline__ unsigned pk(float lo, float hi) { const f32x2 v = {lo, hi}; const bf16x2_t b = __builtin_convertvector(v, bf16x2_t); return __builtin_bit_cast(unsigned, b); }
template <int CTRL> __device__ __forceinline__ float dppf(float v) { return __builtin_bit_cast(float, __builtin_amdgcn_update_dpp(0, __builtin_bit_cast(int, v), CTRL, 0xF, 0xF, false)); }
__device__ __forceinline__ float rdlane(float v, int l) { return __builtin_bit_cast(float, __builtin_amdgcn_readlane(__builtin_bit_cast(int, v), l)); }
__device__ __forceinline__ float wave_sum(float v) {
#pragma unroll
    for (int o = 1; o < 64; o <<= 1) v += __shfl_xor(v, o);
    return v;
}
__device__ __forceinline__ float sigmoidf_(float x) { return 1.f / (1.f + __expf(-x)); }

struct Params { const float* in[20]; float* out; unsigned char* ws; int ph_lo, ph_hi; };

__device__ __forceinline__ unsigned pka(float lo, float hi) { return pg8::cvt_pk_bf16(lo, hi); }
using pg8::Unit;
struct EpiIn {
    static constexpr bool PERM = true, AFTER_DRAIN = false;
    bf16 *GQ, *GK, *GV, *GG, *NQ, *NK, *NVT; float* LR;
    __device__ __forceinline__ void operator()(const f32x4 (&acc)[2][2][4][2], const Unit& u, int wr, int wc, int fr, int fq) const {
        const int pn = u.pn, row0 = u.pm * 256 + wr * 64 + fr;
        if (pn < 10) {
            bf16* base; int ldc, c0; float sc = 1.f;
            if (pn == 0) { base = GQ; ldc = 256; c0 = 0; sc = 0.125f; }
            else if (pn == 1) { base = GK; ldc = 256; c0 = 0; }
            else if (pn < 4) { base = GV; ldc = 512; c0 = (pn - 2) * 256; }
            else if (pn < 6) { base = GG; ldc = 512; c0 = (pn - 4) * 256; }
            else if (pn < 8) { base = NQ; ldc = 512; c0 = (pn - 6) * 256; sc = 0.125f; }
            else { base = NK; ldc = 512; c0 = (pn - 8) * 256; }
            const int col0 = c0 + wc * 32 + 8 * fq;
#pragma unroll
            for (int ai = 0; ai < 2; ++ai)
#pragma unroll
                for (int m = 0; m < 4; ++m) { bf16* rowp = base + (size_t)(row0 + ai * 128 + m * 16) * ldc + col0;
#pragma unroll
                    for (int bj = 0; bj < 2; ++bj) { const f32x4 v0 = acc[ai][bj][m][0] * sc, v1 = acc[ai][bj][m][1] * sc;
                        u32x4 w; w.x = pka(v0[0], v0[1]); w.y = pka(v0[2], v0[3]); w.z = pka(v1[0], v1[1]); w.w = pka(v1[2], v1[3]);
                        *(u32x4*)(rowp + bj * 128) = w; } }
        } else if (pn < 12) {
            const bool odd = fr & 1;
#pragma unroll
            for (int ai = 0; ai < 2; ++ai)
#pragma unroll
                for (int m = 0; m < 4; ++m) { const int tok = row0 + ai * 128 + m * 16;
#pragma unroll
                    for (int bj = 0; bj < 2; ++bj)
#pragma unroll
                        for (int n = 0; n < 2; ++n) { const f32x4 v = acc[ai][bj][m][n]; const int cb = (pn - 10) * 256 + bj * 128 + wc * 32 + 8 * fq + 4 * n;
#pragma unroll
                            for (int p = 0; p < 2; ++p) { const float x0 = v[2 * p], x1 = v[2 * p + 1];
                                const float y = dppf<0xB1>(odd ? x0 : x1);
                                const unsigned w = odd ? pka(y, x1) : pka(x0, y);
                                const int col = cb + 2 * p + (odd ? 1 : 0);
                                *(unsigned*)(NVT + (size_t)col * T + (tok & ~1)) = w; } } }
        } else {
            if (wc == 0) {
#pragma unroll
                for (int ai = 0; ai < 2; ++ai)
#pragma unroll
                    for (int m = 0; m < 4; ++m) { float* rowp = LR + (size_t)(row0 + ai * 128 + m * 16) * 32 + 8 * fq;
                        *(f32x4*)rowp = acc[ai][0][m][0]; *(f32x4*)(rowp + 4) = acc[ai][0][m][1]; }
            }
        }
    }
};
struct EpiRes {
    static constexpr bool PERM = true, AFTER_DRAIN = false;
    const bf16* res; float* out;
    __device__ __forceinline__ void operator()(const f32x4 (&acc)[2][2][4][2], const Unit& u, int wr, int wc, int fr, int fq) const {
        const int row0 = u.pm * 256 + wr * 64 + fr, col0 = u.pn * 256 + wc * 32 + 8 * fq;
#pragma unroll
        for (int ai = 0; ai < 2; ++ai)
#pragma unroll
            for (int m = 0; m < 4; ++m) { const size_t off = (size_t)(row0 + ai * 128 + m * 16) * DM + col0;
#pragma unroll
                for (int bj = 0; bj < 2; ++bj) { const u32x4 r = *(const u32x4*)(res + off + bj * 128);
                    f32x4 a = acc[ai][bj][m][0], b = acc[ai][bj][m][1];
                    a[0] += ALPHA * bflo(r.x); a[1] += ALPHA * bfhi(r.x); a[2] += ALPHA * bflo(r.y); a[3] += ALPHA * bfhi(r.y);
                    b[0] += ALPHA * bflo(r.z); b[1] += ALPHA * bfhi(r.z); b[2] += ALPHA * bflo(r.w); b[3] += ALPHA * bfhi(r.w);
                    *(f32x4*)(out + off + bj * 128) = a; *(f32x4*)(out + off + bj * 128 + 4) = b; } }
    }
};
struct EpiUp {
    static constexpr bool PERM = true, AFTER_DRAIN = false;
    const float* cw; const float* cb; bf16* ACT; bf16* HRAW;
    __device__ __forceinline__ void operator()(const f32x4 (&acc)[2][2][4][2], const Unit& u, int wr, int wc, int fr, int fq) const {
        const int row0 = u.pm * 256 + wr * 64 + fr;
#pragma unroll
        for (int n = 0; n < 2; ++n) {
            const int ch = u.pn * 128 + wc * 32 + 8 * fq + 4 * n;
            f32x4 wa[3], wg[3];
#pragma unroll
            for (int k = 0; k < 3; ++k) { wa[k] = *(const f32x4*)(cw + k * FF2 + ch); wg[k] = *(const f32x4*)(cw + k * FF2 + FF + ch); }
            const f32x4 ba = *(const f32x4*)(cb + ch), bg = *(const f32x4*)(cb + FF + ch);
#pragma unroll
            for (int ai = 0; ai < 2; ++ai) {
                f32x4 ca[4], cg_[4];
#pragma unroll
                for (int m = 0; m < 4; ++m) { ca[m] = acc[ai][0][m][n] * wa[1] + ba; cg_[m] = acc[ai][1][m][n] * wg[1] + bg; }
#pragma unroll
                for (int i = 0; i < 4; ++i) {
                    float ua[4], da[4], ug[4], dg[4];
#pragma unroll
                    for (int m = 0; m < 4; ++m) { ua[m] = dppf<0x121>(acc[ai][0][m][n][i]); da[m] = dppf<0x12F>(acc[ai][0][m][n][i]);
                                                  ug[m] = dppf<0x121>(acc[ai][1][m][n][i]); dg[m] = dppf<0x12F>(acc[ai][1][m][n][i]); }
#pragma unroll
                    for (int m = 0; m < 4; ++m) {
                        const float pa = (fr == 0) ? (m > 0 ? ua[m > 0 ? m - 1 : 0] : 0.f) : ua[m];
                        const float na = (fr == 15) ? (m < 3 ? da[m < 3 ? m + 1 : 3] : 0.f) : da[m];
                        const float pg = (fr == 0) ? (m > 0 ? ug[m > 0 ? m - 1 : 0] : 0.f) : ug[m];
                        const float ng = (fr == 15) ? (m < 3 ? dg[m < 3 ? m + 1 : 3] : 0.f) : dg[m];
                        ca[m][i] += wa[0][i] * pa + wa[2][i] * na;
                        cg_[m][i] += wg[0][i] * pg + wg[2][i] * ng;
                    }
                }
#pragma unroll
                for (int m = 0; m < 4; ++m) {
                    f32x4 o;
#pragma unroll
                    for (int i = 0; i < 4; ++i) o[i] = ca[m][i] * cg_[m][i] * sigmoidf_(cg_[m][i]);
                    u32x2 w; w.x = pka(o[0], o[1]); w.y = pka(o[2], o[3]);
                    *(u32x2*)(ACT + (size_t)(row0 + ai * 128 + m * 16) * FF + ch) = w;
                }
                const int seg = u.pm * 4 + ai * 2 + wr;
                if (fr < 2) { const f32x4 a = acc[ai][0][0][n], g = acc[ai][1][0][n]; bf16* hp = HRAW + (size_t)(seg * 4 + fr) * FF2 + ch;
                    u32x2 w; w.x = pka(a[0], a[1]); w.y = pka(a[2], a[3]); *(u32x2*)hp = w; w.x = pka(g[0], g[1]); w.y = pka(g[2], g[3]); *(u32x2*)(hp + FF) = w; }
                if (fr >= 14) { const f32x4 a = acc[ai][0][3][n], g = acc[ai][1][3][n]; bf16* hp = HRAW + (size_t)(seg * 4 + fr - 12) * FF2 + ch;
                    u32x2 w; w.x = pka(a[0], a[1]); w.y = pka(a[2], a[3]); *(u32x2*)hp = w; w.x = pka(g[0], g[1]); w.y = pka(g[2], g[3]); *(u32x2*)(hp + FF) = w; }
            }
        }
    }
};

struct Frame {
    LAS unsigned char* lds;
    int tid, lane, wave, G, bid;
    const float* in[20]; float* out; unsigned char* ws;
};
__device__ __forceinline__ const float* xrow(const Frame& F, int m) { return m < TP ? F.in[0] + (size_t)m * DM : F.in[1] + (size_t)(m - TP) * DM; }

__device__ __forceinline__ void p0_transpose_item(const float* W, int K, int N, int src_n0, bf16* WT, int dst_n0, int k0, LAS float* scr, int lane) {
#pragma unroll 8
    for (int i = 0; i < 32; ++i) { const int kk = 2 * i + (lane >> 5); scr[kk * 33 + (lane & 31)] = (src_n0 >= 0) ? W[(size_t)(k0 + kk) * N + src_n0 + (lane & 31)] : 0.f; }
    asm volatile("s_waitcnt lgkmcnt(0)" ::: "memory");
    const int c = lane & 7;
#pragma unroll
    for (int j = 0; j < 4; ++j) { const int n = (lane >> 3) + 8 * j; const LAS float* s = scr + (8 * c) * 33 + n;
        u32x4 o; o.x = pk(s[0 * 33], s[1 * 33]); o.y = pk(s[2 * 33], s[3 * 33]); o.z = pk(s[4 * 33], s[5 * 33]); o.w = pk(s[6 * 33], s[7 * 33]);
        *(u32x4*)(WT + (size_t)(dst_n0 + n) * K + k0 + 8 * c) = o; }
    asm volatile("s_waitcnt lgkmcnt(0)" ::: "memory");
}
template <bool OUT_BF16>
__device__ __forceinline__ void ln_row(const float* xr_, const float* g, const float* b, void* orow, int lane) {
    const f32x4* xr = (const f32x4*)xr_ + lane;
    f32x4 v[4]; float s = 0.f;
#pragma unroll
    for (int j = 0; j < 4; ++j) { v[j] = xr[64 * j]; s += (v[j].x + v[j].y) + (v[j].z + v[j].w); }
    const float mean = wave_sum(s) * (1.f / DM); float s2 = 0.f;
#pragma unroll
    for (int j = 0; j < 4; ++j) { v[j] = v[j] - mean; s2 += (v[j].x * v[j].x + v[j].y * v[j].y) + (v[j].z * v[j].z + v[j].w * v[j].w); }
    const float rstd = 1.f / sqrtf(wave_sum(s2) * (1.f / DM) + LN_EPS);
#pragma unroll
    for (int j = 0; j < 4; ++j) { const f32x4 gg = *((const f32x4*)g + lane + 64 * j), bb = *((const f32x4*)b + lane + 64 * j);
        const f32x4 o = v[j] * rstd * gg + bb;
        if (OUT_BF16) { u32x2 w; w.x = pk(o[0], o[1]); w.y = pk(o[2], o[3]); *((u32x2*)orow + lane + 64 * j) = w; }
        else *((f32x4*)orow + lane + 64 * j) = o; }
}
__device__ __forceinline__ void p0_prologue(Frame& F) {
    LAS float* scr = (LAS float*)(F.lds + F.wave * 16384);
    const int gw = F.bid * NWAVES + F.wave, NGW = F.G * NWAVES;
    bf16* WIN = (bf16*)(F.ws + WS_WIN); bf16* WOUT = (bf16*)(F.ws + WS_WOUT); bf16* WUP = (bf16*)(F.ws + WS_WUP); bf16* WDN = (bf16*)(F.ws + WS_WDN);
    constexpr int I_IN = 16 * (NIN / 32), I_OUT = 16 * 32, I_UP = 16 * (FF2 / 32), I_DN = (FF / 64) * 32;
    for (int it = gw; it < I_IN + I_OUT + I_UP + I_DN; it += NGW) {
        int r = it;
        if (r < I_IN) { const int nb = r % (NIN / 32), kb = r / (NIN / 32), d0 = nb * 32;
            const int s0 = d0 < 1536 ? d0 : (d0 < 3072 ? d0 + 32 : (d0 < 3104 ? 1536 : -1));
            p0_transpose_item(F.in[4], DM, 3104, s0, WIN, d0, kb * 64, scr, F.lane); continue; } r -= I_IN;
        if (r < I_OUT) { const int nb = r % 32, kb = r / 32; p0_transpose_item(F.in[11], DM, DM, nb * 32, WOUT, nb * 32, kb * 64, scr, F.lane); continue; } r -= I_OUT;
        if (r < I_UP) { const int nb = r % (FF2 / 32), kb = r / (FF2 / 32), d0 = nb * 32, pn = d0 >> 8, wi = d0 & 255;
            const int s0 = pn * 128 + (wi & 127) + (wi >> 7) * FF;
            p0_transpose_item(F.in[14], DM, FF2, s0, WUP, d0, kb * 64, scr, F.lane); continue; } r -= I_UP;
        { const int nb = r % 32, kb = r / 32; p0_transpose_item(F.in[17], FF, DM, nb * 32, WDN, nb * 32, kb * 64, scr, F.lane); }
    }
    bf16* XN = (bf16*)(F.ws + WS_XN);
    for (int m = gw; m < T; m += NGW) ln_row<true>(xrow(F, m), F.in[2], F.in[3], XN + (size_t)m * DM, F.lane);
}

__device__ __forceinline__ float logsig16(float z) { return -(fmaxf(-z, 0.f) + __logf(1.f + __expf(-fabsf(z)))) * (1.f / 16.f); }
__device__ __forceinline__ void gla_gates(const Frame& F, int gc, LAS float* LRS, LAS float* WT, const float (&wf)[16], const float (&wb)[16], float bf_, float bb_,
                                          float (&laf)[8], float (&lab)[8], float (&Pf)[8], float (&Pb)[8], float& totf, float& totb) {
    const float* LR = (const float*)(F.ws + WS_LR);
    const int w = F.wave, lane = F.lane;
    *(LAS f32x4*)(LRS + F.tid * 4) = *(const f32x4*)(LR + (size_t)gc * 2048 + F.tid * 4);
    __syncthreads();
    float sf = 0.f, sb = 0.f;
#pragma unroll
    for (int t = 0; t < 8; ++t) {
        const LAS float* lr = LRS + (8 * w + t) * 32;
        float zf = bf_, zb = bb_;
#pragma unroll
        for (int q = 0; q < 4; ++q) { const f32x4 a = *(const LAS f32x4*)(lr + 4 * q), b = *(const LAS f32x4*)(lr + 16 + 4 * q);
            zf += a[0] * wf[4 * q] + a[1] * wf[4 * q + 1] + a[2] * wf[4 * q + 2] + a[3] * wf[4 * q + 3];
            zb += b[0] * wb[4 * q] + b[1] * wb[4 * q + 1] + b[2] * wb[4 * q + 2] + b[3] * wb[4 * q + 3]; }
        const float lf = logsig16(zf), lb = logsig16(zb);
        laf[t] = lf; lab[t] = lb; sf += lf; sb += lb; Pf[t] = sf; Pb[t] = sb;
    }
    WT[w * 64 + lane] = sf; WT[(8 + w) * 64 + lane] = sb;
    __syncthreads();
    float of = 0.f, ob = 0.f, tf = 0.f, tb = 0.f;
#pragma unroll
    for (int x = 0; x < 8; ++x) { const float vf = WT[x * 64 + lane], vb = WT[(8 + x) * 64 + lane]; tf += vf; tb += vb; if (x < w) { of += vf; ob += vb; } }
#pragma unroll
    for (int t = 0; t < 8; ++t) { Pf[t] += of; Pb[t] += ob; }
    totf = tf; totb = tb;
}

__device__ __forceinline__ void na_unit(const Frame& F, int gc, int head, int cb, const LAS float* rpb) {
    const bf16* NQ = (const bf16*)(F.ws + WS_NQ); const bf16* NK = (const bf16*)(F.ws + WS_NK); const bf16* NVT = (const bf16*)(F.ws + WS_NVT);
    bf16* MIX = (bf16*)((unsigned char*)F.out + OUT_MIX);
    const int lane = F.lane, fr = lane & 15, fq = lane >> 4;
    const int sb = gc < 512 ? (gc & ~63) : 512, rows = gc < 512 ? 64 : 256, r = gc - sb;
    int rs = r - 4; rs = rs < 0 ? 0 : (rs > rows - 8 ? rows - 8 : rs);
    int bs = 16 * cb - 8; bs = bs < 0 ? 0 : (bs > 32 ? 32 : bs);
    const int qc = 16 * cb + fr; int qcs = qc - 8; qcs = qcs < 0 ? 0 : (qcs > 48 ? 48 : qcs);
    const bf16* qp = NQ + (size_t)(gc * 64 + qc) * 512 + head * 64 + 8 * fq;
    const bf16x8 q0 = *(const bf16x8*)qp, q1 = *(const bf16x8*)(qp + 32);
    f32x4 S[16];
#pragma unroll
    for (int kt = 0; kt < 16; ++kt) {
        const int ktok = (sb + rs + (kt >> 1)) * 64 + bs + 16 * (kt & 1) + fr;
        const bf16* kp = NK + (size_t)ktok * 512 + head * 64 + 8 * fq;
        const bf16x8 k0 = *(const bf16x8*)kp, k1 = *(const bf16x8*)(kp + 32);
        f32x4 a = {0.f, 0.f, 0.f, 0.f};
        a = __builtin_amdgcn_mfma_f32_16x16x32_bf16(k0, q0, a, 0, 0, 0);
        a = __builtin_amdgcn_mfma_f32_16x16x32_bf16(k1, q1, a, 0, 0, 0);
        S[kt] = a;
    }
    float mx = -1e30f;
#pragma unroll
    for (int kt = 0; kt < 16; ++kt) {
        const int dr = rs + (kt >> 1) - r;
#pragma unroll
        for (int i = 0; i < 4; ++i) {
            const int kc = bs + 16 * (kt & 1) + 4 * fq + i;
            int dc = kc - qc; dc = dc < -15 ? -15 : (dc > 15 ? 15 : dc);
            const bool ok = (kc >= qcs) && (kc < qcs + 16);
            const float bias = rpb[(dr + 7) * 31 + dc + 15];
            const float s = ok ? S[kt][i] + bias : -1e30f;
            S[kt][i] = s; mx = fmaxf(mx, s);
        }
    }
    mx = fmaxf(mx, __shfl_xor(mx, 16)); mx = fmaxf(mx, __shfl_xor(mx, 32));
    float sum = 0.f;
#pragma unroll
    for (int kt = 0; kt < 16; ++kt)
#pragma unroll
        for (int i = 0; i < 4; ++i) { const float p = __expf(S[kt][i] - mx); S[kt][i] = p; sum += p; }
    sum += __shfl_xor(sum, 16); sum += __shfl_xor(sum, 32);
    const float inv = 1.f / sum;
    f32x4 O[4];
#pragma unroll
    for (int df = 0; df < 4; ++df) O[df] = (f32x4){0.f, 0.f, 0.f, 0.f};
#pragma unroll
    for (int kk = 0; kk < 8; ++kk) {
        u32x4 pw; pw.x = pk(S[2 * kk][0], S[2 * kk][1]); pw.y = pk(S[2 * kk][2], S[2 * kk][3]); pw.z = pk(S[2 * kk + 1][0], S[2 * kk + 1][1]); pw.w = pk(S[2 * kk + 1][2], S[2 * kk + 1][3]);
        const bf16x8 pf = __builtin_bit_cast(bf16x8, pw);
        const size_t tok0 = (size_t)(sb + rs + kk) * 64 + bs + 4 * fq;
#pragma unroll
        for (int df = 0; df < 4; ++df) {
            const bf16* vp = NVT + (size_t)(head * 64 + 16 * df + fr) * T + tok0;
            u32x4 vw; const u32x2 a0 = *(const u32x2*)vp, a1 = *(const u32x2*)(vp + 16); vw.x = a0.x; vw.y = a0.y; vw.z = a1.x; vw.w = a1.y;
            O[df] = __builtin_amdgcn_mfma_f32_16x16x32_bf16(__builtin_bit_cast(bf16x8, vw), pf, O[df], 0, 0, 0);
        }
    }
    bf16* op = MIX + (size_t)(gc * 64 + qc) * DM + 512 + head * 64 + 4 * fq;
#pragma unroll
    for (int df = 0; df < 4; ++df) { u32x2 w; w.x = pk(O[df][0] * inv, O[df][1] * inv); w.y = pk(O[df][2] * inv, O[df][3] * inv); *(u32x2*)(op + 16 * df) = w; }
}
__device__ __forceinline__ void p2_phase(Frame& F) {
    const bf16* GK = (const bf16*)(F.ws + WS_GK); const bf16* GV = (const bf16*)(F.ws + WS_GV);
    bf16* US = (bf16*)((unsigned char*)F.out + OUT_US); float* DEC = (float*)(F.ws + WS_DEC);
    LAS bf16* KE = (LAS bf16*)F.lds;
    LAS bf16* VT = (LAS bf16*)(F.lds + 18432);
    LAS float* LRS = (LAS float*)(F.lds + 36864);
    LAS float* WT = (LAS float*)(F.lds + 45056);
    LAS float* RPB = (LAS float*)(F.lds + 49152);
    const int lane = F.lane, w = F.wave, fr = lane & 15, fq = lane >> 4;
    const int h = F.bid & 3;
    if ((F.G & 3) != 0) return;
    float wf[16], wb[16];
#pragma unroll
    for (int k = 0; k < 16; ++k) { wf[k] = F.in[5][k * 256 + h * 64 + lane]; wb[k] = F.in[7][k * 256 + h * 64 + lane]; }
    const float bf_ = F.in[6][h * 64 + lane], bb_ = F.in[8][h * 64 + lane];
    for (int i = F.tid; i < 2 * 465; i += NTHR) RPB[i] = F.in[10][(2 * h) * 465 + i];
    __syncthreads();
    for (int u = F.bid; u < NCH * 4; u += F.G) {
        const int gc = u >> 2;
        {
            float laf[8], lab[8], Pf[8], Pb[8], totf, totb;
            gla_gates(F, gc, LRS, WT, wf, wb, bf_, bb_, laf, lab, Pf, Pb, totf, totb);
            float kf[8], kb[8];
#pragma unroll
            for (int t = 0; t < 8; ++t) { const float kv = bf2f(GK[(size_t)(gc * 64 + 8 * w + t) * 256 + h * 64 + lane]);
                kf[t] = kv * __expf(totf - Pf[t]); kb[t] = kv * __expf(Pb[t] - lab[t]); }
            *(LAS u32x4*)(KE + (0 * 64 + lane) * LP + 8 * w) = (u32x4){pk(kf[0], kf[1]), pk(kf[2], kf[3]), pk(kf[4], kf[5]), pk(kf[6], kf[7])};
            *(LAS u32x4*)(KE + (1 * 64 + lane) * LP + 8 * w) = (u32x4){pk(kb[0], kb[1]), pk(kb[2], kb[3]), pk(kb[4], kb[5]), pk(kb[6], kb[7])};
            if (w == 0) { DEC[(size_t)((gc * 4 + h) * 2 + 0) * 64 + lane] = __expf(totf); DEC[(size_t)((gc * 4 + h) * 2 + 1) * 64 + lane] = __expf(totb); }
            const u32x4* vp = (const u32x4*)(GV + (size_t)(gc * 64 + lane) * 512 + h * 128 + 16 * w);
            const u32x4 v0 = vp[0], v1 = vp[1];
            const unsigned vw[8] = {v0.x, v0.y, v0.z, v0.w, v1.x, v1.y, v1.z, v1.w};
#pragma unroll
            for (int i = 0; i < 16; ++i) VT[(16 * w + i) * LP + lane] = (bf16)((i & 1) ? (vw[i >> 1] >> 16) : (vw[i >> 1] & 0xffffu));
        }
        __syncthreads();
        {
            const int dir = w >> 2, mf = w & 3;
            bf16x8 a[2];
#pragma unroll
            for (int ks = 0; ks < 2; ++ks) a[ks] = *(const LAS bf16x8*)(KE + (dir * 64 + 16 * mf + fr) * LP + 32 * ks + 8 * fq);
            bf16* up = US + (size_t)((gc * 4 + h) * 2 + dir) * 8192 + 16 * mf + 4 * fq;
#pragma unroll
            for (int nf = 0; nf < 8; ++nf) {
                f32x4 acc = {0.f, 0.f, 0.f, 0.f};
#pragma unroll
                for (int ks = 0; ks < 2; ++ks) { const bf16x8 b = *(const LAS bf16x8*)(VT + (16 * nf + fr) * LP + 32 * ks + 8 * fq);
                    acc = __builtin_amdgcn_mfma_f32_16x16x32_bf16(a[ks], b, acc, 0, 0, 0); }
                u32x2 o; o.x = pk(acc[0], acc[1]); o.y = pk(acc[2], acc[3]);
                *(u32x2*)(up + (size_t)(16 * nf + fr) * 64) = o;
            }
        }
        na_unit(F, gc, 2 * h + (w >> 2), w & 3, RPB + (w >> 2) * 465);
        __syncthreads();
    }
}

__device__ __forceinline__ void p3_phase(Frame& F) {
    bf16* US = (bf16*)((unsigned char*)F.out + OUT_US); const float* DEC = (const float*)(F.ws + WS_DEC);
    const int gwt = F.wave * F.G + F.bid, NGW = F.G * NWAVES;
    for (int task = gwt; task < 1152; task += NGW) {
        int chain, sub, n, base;
        if (task < 128) { chain = task >> 4; sub = task & 15; n = 256; base = 512; }
        else { const int t2 = task - 128; chain = t2 >> 4; sub = t2 & 15; n = 64; base = (chain >> 3) * 64; chain &= 7; }
        const int h = chain >> 1, dir = chain & 1;
        const int e0 = sub * 512 + F.lane * 8, d0 = e0 & 63;
        float S[8];
#pragma unroll
        for (int i = 0; i < 8; ++i) S[i] = 0.f;
        for (int c0 = 0; c0 < n; c0 += 8) {
            u32x4 uu[8]; f32x4 da[8], db[8];
#pragma unroll
            for (int s = 0; s < 8; ++s) { const int c = dir ? (n - 1 - (c0 + s)) : (c0 + s); const size_t unit = (size_t)(((base + c) * 4 + h) * 2 + dir);
                uu[s] = *(const u32x4*)(US + unit * 8192 + e0); da[s] = *(const f32x4*)(DEC + unit * 64 + d0); db[s] = *(const f32x4*)(DEC + unit * 64 + d0 + 4); }
#pragma unroll
            for (int s = 0; s < 8; ++s) { const int c = dir ? (n - 1 - (c0 + s)) : (c0 + s); const size_t unit = (size_t)(((base + c) * 4 + h) * 2 + dir);
                u32x4 o; o.x = pk(S[0], S[1]); o.y = pk(S[2], S[3]); o.z = pk(S[4], S[5]); o.w = pk(S[6], S[7]);
                *(u32x4*)(US + unit * 8192 + e0) = o;
                S[0] = da[s][0] * S[0] + bflo(uu[s].x); S[1] = da[s][1] * S[1] + bfhi(uu[s].x); S[2] = da[s][2] * S[2] + bflo(uu[s].y); S[3] = da[s][3] * S[3] + bfhi(uu[s].y);
                S[4] = db[s][0] * S[4] + bflo(uu[s].z); S[5] = db[s][1] * S[5] + bfhi(uu[s].z); S[6] = db[s][2] * S[6] + bflo(uu[s].w); S[7] = db[s][3] * S[7] + bfhi(uu[s].w); }
        }
    }
}

__device__ __forceinline__ void p4_phase(Frame& F) {
    const bf16* GQ = (const bf16*)(F.ws + WS_GQ); const bf16* GK = (const bf16*)(F.ws + WS_GK); const bf16* GV = (const bf16*)(F.ws + WS_GV); const bf16* GG = (const bf16*)(F.ws + WS_GG);
    const bf16* US = (const bf16*)((unsigned char*)F.out + OUT_US); bf16* MIX = (bf16*)((unsigned char*)F.out + OUT_MIX);
    const float* ng = F.in[9];
    LAS bf16* QI = (LAS bf16*)F.lds;
    LAS bf16* KI = (LAS bf16*)(F.lds + 18432);
    LAS bf16* VT = (LAS bf16*)(F.lds + 36864);
    LAS float* SS = (LAS float*)(F.lds + 55296);
    LAS float* LRS = (LAS float*)(F.lds + 55808);
    LAS float* WT = (LAS float*)(F.lds + 64000);
    const int lane = F.lane, w = F.wave, fr = lane & 15, fq = lane >> 4;
    const int h = F.bid & 3;
    if ((F.G & 3) != 0) return;
    float wf[16], wb[16];
#pragma unroll
    for (int k = 0; k < 16; ++k) { wf[k] = F.in[5][k * 256 + h * 64 + lane]; wb[k] = F.in[7][k * 256 + h * 64 + lane]; }
    const float bf_ = F.in[6][h * 64 + lane], bb_ = F.in[8][h * 64 + lane];
    for (int u = F.bid; u < NCH * 4; u += F.G) {
        const int gc = u >> 2;
        {
            float laf[8], lab[8], Pf[8], Pb[8], totf, totb;
            gla_gates(F, gc, LRS, WT, wf, wb, bf_, bb_, laf, lab, Pf, Pb, totf, totb);
#pragma unroll
            for (int t = 0; t < 8; ++t) { const int j = 8 * w + t; const size_t ro = (size_t)(gc * 64 + j) * 256 + h * 64 + lane;
                const float qv = bf2f(GQ[ro]), kv = bf2f(GK[ro]);
                const float b0 = Pf[t], b1 = totb - Pb[t] + lab[t];
                QI[(j) * LP + lane] = (bf16)(pk(qv * __expf(b0), 0.f) & 0xffffu); QI[(64 + j) * LP + lane] = (bf16)(pk(qv * __expf(b1), 0.f) & 0xffffu);
                KI[(j) * LP + lane] = (bf16)(pk(kv * __expf(-b0), 0.f) & 0xffffu); KI[(64 + j) * LP + lane] = (bf16)(pk(kv * __expf(-b1), 0.f) & 0xffffu); }
            const u32x4* vp = (const u32x4*)(GV + (size_t)(gc * 64 + lane) * 512 + h * 128 + 16 * w);
            const u32x4 v0 = vp[0], v1 = vp[1];
            const unsigned vw[8] = {v0.x, v0.y, v0.z, v0.w, v1.x, v1.y, v1.z, v1.w};
#pragma unroll
            for (int i = 0; i < 16; ++i) VT[(16 * w + i) * LP + lane] = (bf16)((i & 1) ? (vw[i >> 1] >> 16) : (vw[i >> 1] & 0xffffu));
        }
        __syncthreads();
        const int it = w & 3, vh = w >> 2, ti = 16 * it + fr;
        f32x4 O[4];
        {
            bf16x8 qf[2][2];
#pragma unroll
            for (int d = 0; d < 2; ++d)
#pragma unroll
                for (int ks = 0; ks < 2; ++ks) qf[d][ks] = *(const LAS bf16x8*)(QI + (d * 64 + ti) * LP + 32 * ks + 8 * fq);
            unsigned at[4][2];
#pragma unroll
            for (int jt = 0; jt < 4; ++jt) {
                f32x4 af = {0.f, 0.f, 0.f, 0.f}, ab = {0.f, 0.f, 0.f, 0.f};
#pragma unroll
                for (int ks = 0; ks < 2; ++ks) {
                    const bf16x8 kf = *(const LAS bf16x8*)(KI + (0 * 64 + 16 * jt + fr) * LP + 32 * ks + 8 * fq);
                    const bf16x8 kb = *(const LAS bf16x8*)(KI + (1 * 64 + 16 * jt + fr) * LP + 32 * ks + 8 * fq);
                    af = __builtin_amdgcn_mfma_f32_16x16x32_bf16(kf, qf[0][ks], af, 0, 0, 0);
                    ab = __builtin_amdgcn_mfma_f32_16x16x32_bf16(kb, qf[1][ks], ab, 0, 0, 0);
                }
                float val[4];
#pragma unroll
                for (int r = 0; r < 4; ++r) { const int j = 16 * jt + 4 * fq + r; val[r] = (ti >= j ? af[r] : 0.f) + (ti <= j ? ab[r] : 0.f); }
                at[jt][0] = pk(val[0], val[1]); at[jt][1] = pk(val[2], val[3]);
            }
            const size_t ubase = (size_t)((gc * 4 + h) * 2) * 8192;
#pragma unroll
            for (int v = 0; v < 4; ++v) {
                const int vt = 4 * vh + v;
                f32x4 o = {0.f, 0.f, 0.f, 0.f};
#pragma unroll
                for (int kk = 0; kk < 2; ++kk) {
                    const LAS bf16* vp = VT + (16 * vt + fr) * LP + 32 * kk + 4 * fq;
                    const u32x2 a0 = *(const LAS u32x2*)vp, a1 = *(const LAS u32x2*)(vp + 16);
                    const u32x4 aw = {a0.x, a0.y, a1.x, a1.y}; const u32x4 bw = {at[2 * kk][0], at[2 * kk][1], at[2 * kk + 1][0], at[2 * kk + 1][1]};
                    o = __builtin_amdgcn_mfma_f32_16x16x32_bf16(__builtin_bit_cast(bf16x8, aw), __builtin_bit_cast(bf16x8, bw), o, 0, 0, 0);
                }
#pragma unroll
                for (int d = 0; d < 2; ++d)
#pragma unroll
                    for (int ks = 0; ks < 2; ++ks) {
                        const bf16x8 sf = *(const bf16x8*)(US + ubase + (size_t)d * 8192 + (16 * vt + fr) * 64 + 32 * ks + 8 * fq);
                        o = __builtin_amdgcn_mfma_f32_16x16x32_bf16(sf, qf[d][ks], o, 0, 0, 0);
                    }
                O[v] = o;
            }
            float ss = 0.f;
#pragma unroll
            for (int v = 0; v < 4; ++v) ss += (O[v][0] * O[v][0] + O[v][1] * O[v][1]) + (O[v][2] * O[v][2] + O[v][3] * O[v][3]);
            ss += __shfl_xor(ss, 16); ss += __shfl_xor(ss, 32);
            if (fq == 0) SS[vh * 64 + ti] = ss;
        }
        __syncthreads();
        {
            const float rstd = 1.f / sqrtf((SS[ti] + SS[64 + ti]) * (1.f / 128.f) + RMS_EPS);
            const size_t tok = (size_t)gc * 64 + ti;
#pragma unroll
            for (int v = 0; v < 4; ++v) {
                const int vc = 16 * (4 * vh + v) + 4 * fq;
                const u32x2 gw = *(const u32x2*)(GG + tok * 512 + h * 128 + vc);
                const f32x4 gn = *(const f32x4*)(ng + vc);
                const float g0 = bflo(gw.x), g1 = bfhi(gw.x), g2 = bflo(gw.y), g3 = bfhi(gw.y);
                const float o0 = O[v][0] * rstd * gn[0] * g0 * sigmoidf_(g0), o1 = O[v][1] * rstd * gn[1] * g1 * sigmoidf_(g1);
                const float o2 = O[v][2] * rstd * gn[2] * g2 * sigmoidf_(g2), o3 = O[v][3] * rstd * gn[3] * g3 * sigmoidf_(g3);
                u32x2 ow; ow.x = pk(o0, o1); ow.y = pk(o2, o3);
                *(u32x2*)(MIX + tok * DM + h * 128 + vc) = ow;
            }
        }
        __syncthreads();
    }
}

__device__ __forceinline__ void p8_phase(Frame& F) {
    const bf16* HRAW = (const bf16*)(F.ws + WS_HRAW); bf16* ACT = (bf16*)(F.ws + WS_ACT);
    const float* cw = F.in[15]; const float* cb = F.in[16];
    const int NIT = NCH * 2 * (FF / 8);
    for (int it = F.bid * NTHR + F.tid; it < NIT; it += F.G * NTHR) {
        const int cg8 = it % (FF / 8), rw = it / (FF / 8), seg = rw >> 1, last = rw & 1, ch = cg8 * 8;
        const bool sstart = seg < 512 ? ((seg & 63) == 0) : (seg == 512), send = seg < 512 ? ((seg & 63) == 63) : (seg == NCH - 1);
        const bf16* pc = HRAW + (size_t)(seg * 4 + (last ? 3 : 0)) * FF2 + ch;
        const bf16* pp = last ? HRAW + (size_t)(seg * 4 + 2) * FF2 + ch : (sstart ? nullptr : HRAW + (size_t)((seg - 1) * 4 + 3) * FF2 + ch);
        const bf16* pn = last ? (send ? nullptr : HRAW + (size_t)((seg + 1) * 4 + 0) * FF2 + ch) : HRAW + (size_t)(seg * 4 + 1) * FF2 + ch;
        const u32x4 z4 = {0u, 0u, 0u, 0u};
        const u32x4 ca = *(const u32x4*)pc, cgt = *(const u32x4*)(pc + FF);
        const u32x4 pa = pp ? *(const u32x4*)pp : z4, pg = pp ? *(const u32x4*)(pp + FF) : z4;
        const u32x4 na = pn ? *(const u32x4*)pn : z4, ngt = pn ? *(const u32x4*)(pn + FF) : z4;
        unsigned ow[4];
#pragma unroll
        for (int p = 0; p < 4; ++p) {
            float o[2];
#pragma unroll
            for (int e = 0; e < 2; ++e) {
                const int c = ch + 2 * p + e;
                const float a = e ? bfhi(ca[p]) : bflo(ca[p]), g = e ? bfhi(cgt[p]) : bflo(cgt[p]);
                const float ap = e ? bfhi(pa[p]) : bflo(pa[p]), gp = e ? bfhi(pg[p]) : bflo(pg[p]);
                const float an = e ? bfhi(na[p]) : bflo(na[p]), gn = e ? bfhi(ngt[p]) : bflo(ngt[p]);
                const float av = cw[c] * ap + cw[FF2 + c] * a + cw[2 * FF2 + c] * an + cb[c];
                const float gv = cw[FF + c] * gp + cw[FF2 + FF + c] * g + cw[2 * FF2 + FF + c] * gn + cb[FF + c];
                o[e] = av * gv * sigmoidf_(gv);
            }
            ow[p] = pk(o[0], o[1]);
        }
        *(u32x4*)(ACT + (size_t)(seg * 64 + (last ? 63 : 0)) * FF + ch) = (u32x4){ow[0], ow[1], ow[2], ow[3]};
    }
}

__global__ void __launch_bounds__(NTHR, 2) hymba_fwd(Params prm) {
    extern __shared__ __attribute__((aligned(16))) unsigned char lds_raw[];
    cg::grid_group grid = cg::this_grid();
    Frame F;
    F.lds = (LAS unsigned char*)lds_raw;
    F.tid = threadIdx.x; F.lane = F.tid & 63; F.wave = __builtin_amdgcn_readfirstlane(F.tid >> 6);
    F.G = gridDim.x; F.bid = blockIdx.x;
#pragma unroll
    for (int i = 0; i < 20; ++i) F.in[i] = prm.in[i];
    F.out = prm.out; F.ws = prm.ws;
    const int lo = prm.ph_lo, hi = prm.ph_hi;
#define IN(k) (lo <= (k) && (k) < hi)
#define SEAM(k) do { if (IN(k) && IN((k) + 1)) grid.sync(); } while (0)
    bf16* XN = (bf16*)(F.ws + WS_XN);
    bf16* MIX = (bf16*)((unsigned char*)F.out + OUT_MIX);
    if (IN(0)) { p0_prologue(F); } SEAM(0);
    if (IN(1)) {
        pg8::Gemm g{XN, (const bf16*)(F.ws + WS_WIN), T, NIN, DM}; pg8::StaticOrder S; S.init(T, NIN, F.G, F.bid);
        EpiIn E{(bf16*)(F.ws + WS_GQ), (bf16*)(F.ws + WS_GK), (bf16*)(F.ws + WS_GV), (bf16*)(F.ws + WS_GG), (bf16*)(F.ws + WS_NQ), (bf16*)(F.ws + WS_NK), (bf16*)(F.ws + WS_NVT), (float*)(F.ws + WS_LR)};
        pg8::gemm_phase<EpiIn, pg8::StaticOrder, true, true>(F.lds, g, S, E);
    } SEAM(1);
    if (IN(2)) { p2_phase(F); } SEAM(2);
    if (IN(3)) { p3_phase(F); } SEAM(3);
    if (IN(4)) { p4_phase(F); } SEAM(4);
    if (IN(5)) {
        pg8::Gemm g{MIX, (const bf16*)(F.ws + WS_WOUT), T, DM, DM}; pg8::StaticOrder S; S.init(T, DM, F.G, F.bid);
        EpiRes E{XN, (float*)(F.ws + WS_Y1)};
        pg8::gemm_phase<EpiRes, pg8::StaticOrder, true, true>(F.lds, g, S, E);
    } SEAM(5);
    if (IN(6)) {
        const int gw = F.bid * NWAVES + F.wave, NGW = F.G * NWAVES; const float* Y1 = (const float*)(F.ws + WS_Y1);
        for (int m = gw; m < T; m += NGW) ln_row<true>(Y1 + (size_t)m * DM, F.in[12], F.in[13], XN + (size_t)m * DM, F.lane);
    } SEAM(6);
    if (IN(7)) {
        pg8::Gemm g{XN, (const bf16*)(F.ws + WS_WUP), T, FF2, DM}; pg8::StaticOrder S; S.init(T, FF2, F.G, F.bid);
        EpiUp E{F.in[15], F.in[16], (bf16*)(F.ws + WS_ACT), (bf16*)(F.ws + WS_HRAW)};
        pg8::gemm_phase<EpiUp, pg8::StaticOrder, true, true>(F.lds, g, S, E);
    } SEAM(7);
    if (IN(8)) { p8_phase(F); } SEAM(8);
    if (IN(9)) {
        pg8::Gemm g{(const bf16*)(F.ws + WS_ACT), (const bf16*)(F.ws + WS_WDN), T, DM, FF}; pg8::StaticOrder S; S.init(T, DM, F.G, F.bid);
        EpiRes E{XN, F.out};
        pg8::gemm_phase<EpiRes, pg8::StaticOrder, true, true>(F.lds, g, S, E);
    } SEAM(9);
    if (IN(10)) {
        const int gw = F.bid * NWAVES + F.wave, NGW = F.G * NWAVES;
        for (int m = gw; m < T; m += NGW) ln_row<false>(F.out + (size_t)m * DM, F.in[18], F.in[19], F.out + (size_t)m * DM, F.lane);
    }
#if DBG_STOP < 11
    if (IN(11)) {
        const u32x4* src = (const u32x4*)((const unsigned char*)F.out + (DBG_STOP == 5 ? OUT_MIX : OUT_US)); u32x4* dst = (u32x4*)(F.ws + WS_C);
        for (size_t i = (size_t)F.bid * NTHR + F.tid; i < (size_t)T * DM / 8; i += (size_t)F.G * NTHR) dst[i] = src[i];
    }
    if (IN(12)) {
        const bf16* src = (const bf16*)(F.ws + WS_C);
        for (size_t i = (size_t)F.bid * NTHR + F.tid; i < (size_t)T * DM; i += (size_t)F.G * NTHR) F.out[i] = bf2f(src[i]);
    }
#endif
#undef IN
#undef SEAM
}

constexpr int N_PHASES = 11;
extern "C" void kernel_launch(void* const* d_in, const int* in_sizes, int n_in, void* d_out, int out_size, void* d_ws, size_t ws_size, hipStream_t stream) {
    static int grid = 0;
    if (grid == 0) {
        if (n_in != 20 || out_size != T * DM || ws_size < WS_END) { fprintf(stderr, "kernel_launch: unexpected shapes (n_in %d out %d ws %zu)\n", n_in, out_size, ws_size); grid = -1; return; }
        int dev = 0, cus = 0, per_cu = 0;
        hipGetDevice(&dev); hipDeviceGetAttribute(&cus, hipDeviceAttributeMultiprocessorCount, dev);
        if (hipFuncSetAttribute((const void*)hymba_fwd, hipFuncAttributeMaxDynamicSharedMemorySize, LDS_BYTES) != hipSuccess) { fprintf(stderr, "kernel_launch: hipFuncSetAttribute failed\n"); grid = -1; return; }
        if (hipOccupancyMaxActiveBlocksPerMultiprocessor(&per_cu, (const void*)hymba_fwd, NTHR, LDS_BYTES) != hipSuccess || per_cu < 1) { fprintf(stderr, "kernel_launch: occupancy query says %d\n", per_cu); per_cu = 1; }
        (void)hipGetLastError();
        grid = cus * 1;
    }
    if (grid < 0) return;
    Params p{};
    for (int i = 0; i < 20; ++i) p.in[i] = (const float*)d_in[i];
    p.out = (float*)d_out; p.ws = (unsigned char*)d_ws;
#if MK_N_LAUNCHES == 1
    p.ph_lo = 0; p.ph_hi = N_PHASES;
    void* args[] = {&p};
    hipError_t e = hipLaunchCooperativeKernel((const void*)hymba_fwd, dim3(grid), dim3(NTHR), args, LDS_BYTES, stream);
    if (e != hipSuccess) fprintf(stderr, "cooperative launch failed: %s (grid %d)\n", hipGetErrorString(e), grid);
#else
    for (int k = 0; k < 13; ++k) { if (k >= DBG_STOP && k < 11) continue; if (k >= 11 && DBG_STOP >= 11) continue; p.ph_lo = k; p.ph_hi = k + 1; hipLaunchKernelGGL(hymba_fwd, dim3(grid), dim3(NTHR), LDS_BYTES, stream, p); }
#endif
}
```

```cpp
#include <hip/hip_runtime.h>
#include <hip/hip_cooperative_groups.h>
#include <cstdio>
#include <cstdint>
namespace cg = cooperative_groups;
#ifndef MK_N_LAUNCHES
#define MK_N_LAUNCHES 1
#endif
#ifndef DBG_STOP
#define DBG_STOP 11
#endif
#ifndef PROBE_REP
#define PROBE_REP 0
#endif
namespace pg8 {
#define PG8_LAS __attribute__((address_space(3)))
typedef unsigned short bf16_t;
typedef short bf16x8 __attribute__((ext_vector_type(8)));
typedef float f32x4 __attribute__((ext_vector_type(4)));
typedef unsigned u32x4 __attribute__((ext_vector_type(4)));
constexpr int BM = 256, BK = 64, HALF = 128, HTB = HALF * BK * 2  , STAGE_BYTES = 8 * HTB, NXCD = 8, WGM = 8;

__host__ __device__ __forceinline__ int lds_byte(int r, int c) { const int st = (r >> 4) * 2 + (c >> 5), rr = r & 15, cc = c & 31, ob = rr * 64 + cc * 2; return st * 1024 + (ob ^ (((ob >> 9) & 1) << 5)); }
__host__ __device__ __forceinline__ void stage_rc(int b, int& R, int& C) { const int st = b / 1024, sb = b % 1024, swz = sb ^ (((sb >> 9) & 1) << 5); R = (st >> 1) * 16 + swz / 64; C = (st & 1) * 32 + (swz % 64) / 2; }
__host__ __device__ __forceinline__ int perm32(int rho) { const int n = rho >> 4, i = rho & 15; return 8 * (i >> 2) + 4 * n + (i & 3); }

struct Unit { int pm, pn; };
struct Gemm { const bf16_t* A; const bf16_t* Bt; int M, N, K; };

struct StaticOrder {
    int nM, nN, nwg, G, c;
    __host__ __device__ void init(int M, int N, int G_, int c_) { nM = M / BM; nN = N / BM; nwg = nM * nN; G = G_; c = c_; }
    __host__ __device__ bool next(int i, Unit& u) const {
        const long L = (long)i * G + c; if (L >= nwg) return false;
        int wgid = (int)L; { const int q = nwg / NXCD, r = nwg % NXCD, xcd = wgid % NXCD, off = wgid / NXCD; wgid = (xcd < r ? xcd * (q + 1) : r * (q + 1) + (xcd - r) * q) + off; }
        const int nig = WGM * nN, gid = wgid / nig, fm = gid * WGM, gsz = (nM - fm) < WGM ? (nM - fm) : WGM;
        u.pm = fm + ((wgid % nig) % gsz); u.pn = (wgid % nig) / gsz; return true;
    }
    __device__ __forceinline__ void a_ready(const Unit&) const {}
    __device__ __forceinline__ void done(const Unit&) const {}
};

__device__ __forceinline__ unsigned cvt_pk_bf16(float lo, float hi) { unsigned r; asm volatile("v_cvt_pk_bf16_f32 %0, %1, %2" : "=v"(r) : "v"(lo), "v"(hi)); return r; }
template <class Epi, class Sched, bool ALIGN_EPI = false, bool SP2 = false>
__device__ __forceinline__ void gemm_phase(PG8_LAS unsigned char* lds, const Gemm g, const Sched& S, const Epi& E) {
    const int tid = threadIdx.x, wid = __builtin_amdgcn_readfirstlane(tid >> 6), lane = tid & 63, wr = wid >> 2, wc = wid & 3, fr = lane & 15, fq = lane >> 4;
    const int K = g.K, nt = K / BK;
    unsigned voffA[2], voffB[2];
#pragma unroll
    for (int i = 0; i < 2; ++i) { int R, C; stage_rc(tid * 16 + i * 8192, R, C); const int Rb = Epi::PERM ? ((R & ~31) + perm32(R & 31)) : R;
        voffA[i] = (unsigned)(R * K + C) * 2u; voffB[i] = (unsigned)(Rb * K + C) * 2u; }
    const size_t kstep = (size_t)(BK * 2);
    const size_t hstep = (size_t)HALF * K * 2;
    const size_t tstep = 2 * hstep;
    const unsigned ldsw = (unsigned)wid * 1024u;
    const int aoff = lds_byte(wr * 64 + fr, fq * 8), boff = lds_byte(wc * 32 + fr, fq * 8);
#define PG8_SA(b, h) (((b) * 2 + (h)) * HTB)
#define PG8_SB(b, h) ((4 + (b) * 2 + (h)) * HTB)
#define PG8_STAGE(bufoff, gbase, voff) do { _Pragma("unroll") for (int _i = 0; _i < 2; ++_i) \
        __builtin_amdgcn_global_load_lds((const unsigned*)((const char*)(gbase) + (voff)[_i]), (PG8_LAS unsigned*)(lds + (bufoff) + ldsw + _i * 8192), 16, 0, 0); } while (0)
#define PG8_LDA(dst, b, h) do { _Pragma("unroll") for (int m = 0; m < 4; ++m) _Pragma("unroll") for (int k = 0; k < 2; ++k) dst[m][k] = *(const PG8_LAS bf16x8*)(lds + PG8_SA(b, h) + aoff + m * 2048 + k * 1024); } while (0)
#define PG8_LDB(dst, b, h) do { _Pragma("unroll") for (int n = 0; n < 2; ++n) _Pragma("unroll") for (int k = 0; k < 2; ++k) dst[n][k] = *(const PG8_LAS bf16x8*)(lds + PG8_SB(b, h) + boff + n * 2048 + k * 1024); } while (0)
#define PG8_MMA(ai, bj, At, Bt) do { __builtin_amdgcn_s_setprio(1); _Pragma("unroll") for (int m = 0; m < 4; ++m) _Pragma("unroll") for (int n = 0; n < 2; ++n) _Pragma("unroll") for (int k = 0; k < 2; ++k) \
        acc[ai][bj][m][n] = __builtin_amdgcn_mfma_f32_16x16x32_bf16(Bt[n][k], At[m][k], acc[ai][bj][m][n], 0, 0, 0); __builtin_amdgcn_s_setprio(0); } while (0)
#define PG8_WAIT_V(n) asm volatile("s_waitcnt vmcnt(" #n ")" ::: "memory")
#define PG8_WAIT_L(n) asm volatile("s_waitcnt lgkmcnt(" #n ")" ::: "memory")
#define PG8_BAR __builtin_amdgcn_s_barrier()
#define PG8_SCHED __builtin_amdgcn_sched_barrier(0)
    Unit cur, nxt; int ui = 0;
    if (!S.next(0, cur)) return;
    f32x4 acc[2][2][4][2];
#pragma unroll
    for (int a = 0; a < 2; ++a)
#pragma unroll
        for (int b = 0; b < 2; ++b)
#pragma unroll
            for (int m = 0; m < 4; ++m)
#pragma unroll
                for (int n = 0; n < 2; ++n) acc[a][b][m][n] = (f32x4){0.f, 0.f, 0.f, 0.f};
    bf16x8 At[4][2], B0[2][2], B1[2][2];
    const char* cA = (const char*)g.A + (size_t)cur.pm * tstep; const char* cB = (const char*)g.Bt + (size_t)cur.pn * tstep;
    S.a_ready(cur);
    if constexpr (SP2) {
        PG8_STAGE(PG8_SB(0, 0), cB, voffB); PG8_STAGE(PG8_SB(0, 1), cB + hstep, voffB); PG8_STAGE(PG8_SA(0, 0), cA, voffA); PG8_STAGE(PG8_SA(0, 1), cA + hstep, voffA);
        if (wr == 1) PG8_BAR;
        PG8_WAIT_V(2); PG8_BAR;
        PG8_STAGE(PG8_SB(1, 0), cB + kstep, voffB); PG8_STAGE(PG8_SA(1, 0), cA + kstep, voffA); PG8_STAGE(PG8_SB(1, 1), cB + hstep + kstep, voffB);
        PG8_WAIT_V(6); PG8_BAR;
    } else {
        PG8_STAGE(PG8_SB(0, 0), cB, voffB); PG8_STAGE(PG8_SA(0, 0), cA, voffA); PG8_STAGE(PG8_SB(0, 1), cB + hstep, voffB); PG8_STAGE(PG8_SA(0, 1), cA + hstep, voffA);
        if (wr == 1) PG8_BAR;
        PG8_WAIT_V(4); PG8_BAR;
        PG8_STAGE(PG8_SB(1, 0), cB + kstep, voffB); PG8_STAGE(PG8_SA(1, 0), cA + kstep, voffA); PG8_STAGE(PG8_SB(1, 1), cB + hstep + kstep, voffB);
        PG8_WAIT_V(6); PG8_BAR;
    }
    for (;;) {
        const bool has_next = S.next(ui + 1, nxt);
        const char* nA = has_next ? (const char*)g.A + (size_t)nxt.pm * tstep : cA; const char* nB = has_next ? (const char*)g.Bt + (size_t)nxt.pn * tstep : cB;
        for (int t = 0; t < nt; t += 2) {
            const bool last = (t == nt - 2);
            const char* a1 = cA + (size_t)(t + 1) * kstep;
            const char* a2 = last ? nA : cA + (size_t)(t + 2) * kstep; const char* b2 = last ? nB : cB + (size_t)(t + 2) * kstep;
            const char* a3 = a2 + kstep; const char* b3 = b2 + kstep;
            if (last && has_next) S.a_ready(nxt);
            if constexpr (SP2) {
            PG8_LDB(B0, 0, 0); PG8_LDB(B1, 0, 1); PG8_SCHED; PG8_LDA(At, 0, 0); PG8_STAGE(PG8_SA(1, 1), a1 + hstep, voffA);
            PG8_WAIT_V(8); PG8_WAIT_L(0); PG8_BAR; PG8_MMA(0, 0, At, B0); PG8_MMA(0, 1, At, B1); PG8_BAR; PG8_SCHED;
            PG8_LDA(At, 0, 1); PG8_STAGE(PG8_SB(0, 0), b2, voffB); PG8_STAGE(PG8_SB(0, 1), b2 + hstep, voffB); PG8_STAGE(PG8_SA(0, 0), a2, voffA);
            PG8_WAIT_V(8); PG8_WAIT_L(0); PG8_BAR; PG8_MMA(1, 0, At, B0); PG8_MMA(1, 1, At, B1); PG8_BAR; PG8_SCHED;
            PG8_LDB(B0, 1, 0); PG8_LDB(B1, 1, 1); PG8_SCHED; PG8_LDA(At, 1, 0); PG8_STAGE(PG8_SA(0, 1), a2 + hstep, voffA);
            PG8_WAIT_V(8); PG8_WAIT_L(0); PG8_BAR; PG8_MMA(0, 0, At, B0); PG8_MMA(0, 1, At, B1); PG8_BAR; PG8_SCHED;
            PG8_LDA(At, 1, 1); PG8_STAGE(PG8_SB(1, 0), b3, voffB); PG8_STAGE(PG8_SB(1, 1), b3 + hstep, voffB); PG8_STAGE(PG8_SA(1, 0), a3, voffA);
            PG8_WAIT_V(8); PG8_WAIT_L(0); PG8_BAR; PG8_MMA(1, 0, At, B0); PG8_MMA(1, 1, At, B1); PG8_BAR; PG8_SCHED;
            } else {
            PG8_LDB(B0, 0, 0); PG8_SCHED; PG8_LDA(At, 0, 0); PG8_STAGE(PG8_SA(1, 1), a1 + hstep, voffA);
            PG8_WAIT_L(8); PG8_BAR; PG8_WAIT_L(0); PG8_MMA(0, 0, At, B0); PG8_BAR; PG8_SCHED;
            PG8_LDB(B1, 0, 1); PG8_STAGE(PG8_SB(0, 0), b2, voffB);
            PG8_BAR; PG8_WAIT_L(0); PG8_MMA(0, 1, At, B1); PG8_BAR;
            PG8_LDA(At, 0, 1); PG8_STAGE(PG8_SA(0, 0), a2, voffA);
            PG8_BAR; PG8_WAIT_L(0); PG8_MMA(1, 0, At, B0); PG8_BAR; PG8_SCHED;
            PG8_STAGE(PG8_SB(0, 1), b2 + hstep, voffB);
            PG8_WAIT_V(6); PG8_BAR; PG8_MMA(1, 1, At, B1); PG8_BAR;
            PG8_LDB(B0, 1, 0); PG8_SCHED; PG8_LDA(At, 1, 0); PG8_STAGE(PG8_SA(0, 1), a2 + hstep, voffA);
            PG8_WAIT_L(8); PG8_BAR; PG8_WAIT_L(0); PG8_MMA(0, 0, At, B0); PG8_BAR; PG8_SCHED;
            PG8_LDB(B1, 1, 1); PG8_STAGE(PG8_SB(1, 0), b3, voffB);
            PG8_BAR; PG8_WAIT_L(0); PG8_MMA(0, 1, At, B1); PG8_BAR;
            PG8_LDA(At, 1, 1); PG8_STAGE(PG8_SA(1, 0), a3, voffA);
            PG8_BAR; PG8_WAIT_L(0); PG8_MMA(1, 0, At, B0); PG8_BAR; PG8_SCHED;
            PG8_STAGE(PG8_SB(1, 1), b3 + hstep, voffB);
            PG8_WAIT_V(6); PG8_BAR; PG8_MMA(1, 1, At, B1); PG8_BAR;
            }
        }
        if constexpr (ALIGN_EPI) { if (wr == 0) PG8_BAR; }
        if constexpr (!Epi::AFTER_DRAIN) { E(acc, cur, wr, wc, fr, fq); S.done(cur); }
        if (!has_next) break;
#pragma unroll
        for (int a = 0; a < 2; ++a)
#pragma unroll
            for (int b = 0; b < 2; ++b)
#pragma unroll
                for (int m = 0; m < 4; ++m)
#pragma unroll
                    for (int n = 0; n < 2; ++n) acc[a][b][m][n] = (f32x4){0.f, 0.f, 0.f, 0.f};
        cur = nxt; cA = nA; cB = nB; ++ui;
        if constexpr (ALIGN_EPI) { if (wr == 1) PG8_BAR; }
    }
    PG8_WAIT_V(0);
    if constexpr (!ALIGN_EPI) { if (wr == 0) PG8_BAR; }
    PG8_BAR;
    if constexpr (Epi::AFTER_DRAIN) { E.fused(acc, cur, wr, wc, fr, fq, lds, wid, lane); S.done(cur); }
#undef PG8_SA
#undef PG8_SB
#undef PG8_STAGE
#undef PG8_LDA
#undef PG8_LDB
#undef PG8_MMA
#undef PG8_WAIT_V
#undef PG8_WAIT_L
#undef PG8_BAR
#undef PG8_SCHED
}
}


#define LAS __attribute__((address_space(3)))
typedef unsigned short bf16;
typedef float f32x4 __attribute__((ext_vector_type(4)));
typedef float f32x2 __attribute__((ext_vector_type(2)));
typedef short bf16x8 __attribute__((ext_vector_type(8)));
typedef short s16x4 __attribute__((ext_vector_type(4)));
typedef unsigned u32x4 __attribute__((ext_vector_type(4)));
typedef unsigned u32x2 __attribute__((ext_vector_type(2)));

constexpr int NWAVES = 8, NTHR = 512;
constexpr int T = 49152, DM = 1024, TP = 32768;
constexpr int NIN = 3328;
constexpr int FF = 2816, FF2 = 5632;
constexpr int NCH = T / 64;
constexpr float ALPHA = 1.189207115002721f;
constexpr float LN_EPS = 1e-5f, RMS_EPS = 1e-6f;
constexpr size_t MiB = 1u << 20;
constexpr size_t WS_WIN = 1 * MiB, WS_WOUT = 8 * MiB, WS_WUP = 10 * MiB, WS_WDN = 21 * MiB, WS_XN = 27 * MiB, WS_C = 123 * MiB;
constexpr size_t WS_GQ = WS_C, WS_GK = WS_C + 24 * MiB, WS_GV = WS_C + 48 * MiB, WS_GG = WS_C + 96 * MiB, WS_NQ = WS_C + 144 * MiB, WS_NK = WS_C + 192 * MiB,
                 WS_NVT = WS_C + 240 * MiB, WS_LR = WS_C + 288 * MiB, WS_DEC = WS_C + 294 * MiB;
constexpr size_t WS_Y1 = WS_C, WS_ACT = WS_C, WS_HRAW = WS_C + 264 * MiB, WS_END = WS_C + 297 * MiB;
constexpr size_t OUT_MIX = 0, OUT_US = 96 * MiB;
constexpr int LDS_BYTES = 147456;
constexpr int LP = 72;

__device__ __forceinline__ float bf2f(unsigned short b) { return __builtin_bit_cast(float, (unsigned)b << 16); }
__device__ __forceinline__ float bflo(unsigned w) { return __builtin_bit_cast(float, w << 16); }
__device__ __forceinline__ float bfhi(unsigned w) { return __builtin_bit_cast(float, w & 0xffff0000u); }
typedef __bf16 bf16x2_t __attribute__((ext_vector_type(2)));
__device__ __forceinline__ unsigned pk(float lo, float hi) { const f32x2 v = {lo, hi}; const bf16x2_t b = __builtin_convertvector(v, bf16x2_t); return __builtin_bit_cast(unsigned, b); }
template <int CTRL> __device__ __forceinline__ float dppf(float v) { return __builtin_bit_cast(float, __builtin_amdgcn_update_dpp(0, __builtin_bit_cast(int, v), CTRL, 0xF, 0xF, false)); }
__device__ __forceinline__ float rdlane(float v, int l) { return __builtin_bit_cast(float, __builtin_amdgcn_readlane(__builtin_bit_cast(int, v), l)); }
__device__ __forceinline__ float wave_sum(float v) {
#pragma unroll
    for (int o = 1; o < 64; o <<= 1) v += __shfl_xor(v, o);
    return v;
}
__device__ __forceinline__ float sigmoidf_(float x) { return 1.f / (1.f + __expf(-x)); }

struct Params { const float* in[20]; float* out; unsigned char* ws; int ph_lo, ph_hi; };

__device__ __forceinline__ unsigned pka(float lo, float hi) { return pg8::cvt_pk_bf16(lo, hi); }
using pg8::Unit;
struct EpiIn {
    static constexpr bool PERM = true, AFTER_DRAIN = false;
    bf16 *GQ, *GK, *GV, *GG, *NQ, *NK, *NVT; float* LR;
    __device__ __forceinline__ void operator()(const f32x4 (&acc)[2][2][4][2], const Unit& u, int wr, int wc, int fr, int fq) const {
        const int pn = u.pn, row0 = u.pm * 256 + wr * 64 + fr;
        if (pn < 10) {
            bf16* base; int ldc, c0; float sc = 1.f;
            if (pn == 0) { base = GQ; ldc = 256; c0 = 0; sc = 0.125f; }
            else if (pn == 1) { base = GK; ldc = 256; c0 = 0; }
            else if (pn < 4) { base = GV; ldc = 512; c0 = (pn - 2) * 256; }
            else if (pn < 6) { base = GG; ldc = 512; c0 = (pn - 4) * 256; }
            else if (pn < 8) { base = NQ; ldc = 512; c0 = (pn - 6) * 256; sc = 0.125f; }
            else { base = NK; ldc = 512; c0 = (pn - 8) * 256; }
            const int col0 = c0 + wc * 32 + 8 * fq;
#pragma unroll
            for (int ai = 0; ai < 2; ++ai)
#pragma unroll
                for (int m = 0; m < 4; ++m) { bf16* rowp = base + (size_t)(row0 + ai * 128 + m * 16) * ldc + col0;
#pragma unroll
                    for (int bj = 0; bj < 2; ++bj) { const f32x4 v0 = acc[ai][bj][m][0] * sc, v1 = acc[ai][bj][m][1] * sc;
                        u32x4 w; w.x = pka(v0[0], v0[1]); w.y = pka(v0[2], v0[3]); w.z = pka(v1[0], v1[1]); w.w = pka(v1[2], v1[3]);
                        *(u32x4*)(rowp + bj * 128) = w; } }
        } else if (pn < 12) {
            const bool odd = fr & 1;
#pragma unroll
            for (int ai = 0; ai < 2; ++ai)
#pragma unroll
                for (int m = 0; m < 4; ++m) { const int tok = row0 + ai * 128 + m * 16;
#pragma unroll
                    for (int bj = 0; bj < 2; ++bj)
#pragma unroll
                        for (int n = 0; n < 2; ++n) { const f32x4 v = acc[ai][bj][m][n]; const int cb = (pn - 10) * 256 + bj * 128 + wc * 32 + 8 * fq + 4 * n;
#pragma unroll
                            for (int p = 0; p < 2; ++p) { const float x0 = v[2 * p], x1 = v[2 * p + 1];
                                const float y = dppf<0xB1>(odd ? x0 : x1);
                                const unsigned w = odd ? pka(y, x1) : pka(x0, y);
                                const int col = cb + 2 * p + (odd ? 1 : 0);
                                *(unsigned*)(NVT + (size_t)col * T + (tok & ~1)) = w; } } }
        } else {
            if (wc == 0) {
#pragma unroll
                for (int ai = 0; ai < 2; ++ai)
#pragma unroll
                    for (int m = 0; m < 4; ++m) { float* rowp = LR + (size_t)(row0 + ai * 128 + m * 16) * 32 + 8 * fq;
                        *(f32x4*)rowp = acc[ai][0][m][0]; *(f32x4*)(rowp + 4) = acc[ai][0][m][1]; }
            }
        }
    }
};
struct EpiRes {
    static constexpr bool PERM = true, AFTER_DRAIN = false;
    const bf16* res; float* out;
    __device__ __forceinline__ void operator()(const f32x4 (&acc)[2][2][4][2], const Unit& u, int wr, int wc, int fr, int fq) const {
        const int row0 = u.pm * 256 + wr * 64 + fr, col0 = u.pn * 256 + wc * 32 + 8 * fq;
#pragma unroll
        for (int ai = 0; ai < 2; ++ai)
#pragma unroll
            for (int m = 0; m < 4; ++m) { const size_t off = (size_t)(row0 + ai * 128 + m * 16) * DM + col0;
#pragma unroll
                for (int bj = 0; bj < 2; ++bj) { const u32x4 r = *(const u32x4*)(res + off + bj * 128);
                    f32x4 a = acc[ai][bj][m][0], b = acc[ai][bj][m][1];
                    a[0] += ALPHA * bflo(r.x); a[1] += ALPHA * bfhi(r.x); a[2] += ALPHA * bflo(r.y); a[3] += ALPHA * bfhi(r.y);
                    b[0] += ALPHA * bflo(r.z); b[1] += ALPHA * bfhi(r.z); b[2] += ALPHA * bflo(r.w); b[3] += ALPHA * bfhi(r.w);
                    *(f32x4*)(out + off + bj * 128) = a; *(f32x4*)(out + off + bj * 128 + 4) = b; } }
    }
};
struct EpiUp {
    static constexpr bool PERM = true, AFTER_DRAIN = false;
    const float* cw; const float* cb; bf16* ACT; bf16* HRAW;
    __device__ __forceinline__ void operator()(const f32x4 (&acc)[2][2][4][2], const Unit& u, int wr, int wc, int fr, int fq) const {
        const int row0 = u.pm * 256 + wr * 64 + fr;
#pragma unroll
        for (int n = 0; n < 2; ++n) {
            const int ch = u.pn * 128 + wc * 32 + 8 * fq + 4 * n;
            f32x4 wa[3], wg[3];
#pragma unroll
            for (int k = 0; k < 3; ++k) { wa[k] = *(const f32x4*)(cw + k * FF2 + ch); wg[k] = *(const f32x4*)(cw + k * FF2 + FF + ch); }
            const f32x4 ba = *(const f32x4*)(cb + ch), bg = *(const f32x4*)(cb + FF + ch);
#pragma unroll
            for (int ai = 0; ai < 2; ++ai) {
                f32x4 ca[4], cg_[4];
#pragma unroll
                for (int m = 0; m < 4; ++m) { ca[m] = acc[ai][0][m][n] * wa[1] + ba; cg_[m] = acc[ai][1][m][n] * wg[1] + bg; }
#pragma unroll
                for (int i = 0; i < 4; ++i) {
                    float ua[4], da[4], ug[4], dg[4];
#pragma unroll
                    for (int m = 0; m < 4; ++m) { ua[m] = dppf<0x121>(acc[ai][0][m][n][i]); da[m] = dppf<0x12F>(acc[ai][0][m][n][i]);
                                                  ug[m] = dppf<0x121>(acc[ai][1][m][n][i]); dg[m] = dppf<0x12F>(acc[ai][1][m][n][i]); }
#pragma unroll
                    for (int m = 0; m < 4; ++m) {
                        const float pa = (fr == 0) ? (m > 0 ? ua[m > 0 ? m - 1 : 0] : 0.f) : ua[m];
                        const float na = (fr == 15) ? (m < 3 ? da[m < 3 ? m + 1 : 3] : 0.f) : da[m];
                        const float pg = (fr == 0) ? (m > 0 ? ug[m > 0 ? m - 1 : 0] : 0.f) : ug[m];
                        const float ng = (fr == 15) ? (m < 3 ? dg[m < 3 ? m + 1 : 3] : 0.f) : dg[m];
                        ca[m][i] += wa[0][i] * pa + wa[2][i] * na;
                        cg_[m][i] += wg[0][i] * pg + wg[2][i] * ng;
                    }
                }
#pragma unroll
                for (int m = 0; m < 4; ++m) {
                    f32x4 o;
#pragma unroll
                    for (int i = 0; i < 4; ++i) o[i] = ca[m][i] * cg_[m][i] * sigmoidf_(cg_[m][i]);
                    u32x2 w; w.x = pka(o[0], o[1]); w.y = pka(o[2], o[3]);
                    *(u32x2*)(ACT + (size_t)(row0 + ai * 128 + m * 16) * FF + ch) = w;
                }
                const int seg = u.pm * 4 + ai * 2 + wr;
                if (fr < 2) { const f32x4 a = acc[ai][0][0][n], g = acc[ai][1][0][n]; bf16* hp = HRAW + (size_t)(seg * 4 + fr) * FF2 + ch;
                    u32x2 w; w.x = pka(a[0], a[1]); w.y = pka(a[2], a[3]); *(u32x2*)hp = w; w.x = pka(g[0], g[1]); w.y = pka(g[2], g[3]); *(u32x2*)(hp + FF) = w; }
                if (fr >= 14) { const f32x4 a = acc[ai][0][3][n], g = acc[ai][1][3][n]; bf16* hp = HRAW + (size_t)(seg * 4 + fr - 12) * FF2 + ch;
                    u32x2 w; w.x = pka(a[0], a[1]); w.y = pka(a[2], a[3]); *(u32x2*)hp = w; w.x = pka(g[0], g[1]); w.y = pka(g[2], g[3]); *(u32x2*)(hp + FF) = w; }
            }
        }
    }
};

struct Frame {
    LAS unsigned char* lds;
    int tid, lane, wave, G, bid;
    const float* in[20]; float* out; unsigned char* ws;
};
__device__ __forceinline__ const float* xrow(const Frame& F, int m) { return m < TP ? F.in[0] + (size_t)m * DM : F.in[1] + (size_t)(m - TP) * DM; }

__device__ __forceinline__ void p0_transpose_item(const float* W, int K, int N, int src_n0, bf16* WT, int dst_n0, int k0, LAS float* scr, int lane) {
#pragma unroll 8
    for (int i = 0; i < 32; ++i) { const int kk = 2 * i + (lane >> 5); scr[kk * 33 + (lane & 31)] = (src_n0 >= 0) ? W[(size_t)(k0 + kk) * N + src_n0 + (lane & 31)] : 0.f; }
    asm volatile("s_waitcnt lgkmcnt(0)" ::: "memory");
    const int c = lane & 7;
#pragma unroll
    for (int j = 0; j < 4; ++j) { const int n = (lane >> 3) + 8 * j; const LAS float* s = scr + (8 * c) * 33 + n;
        u32x4 o; o.x = pk(s[0 * 33], s[1 * 33]); o.y = pk(s[2 * 33], s[3 * 33]); o.z = pk(s[4 * 33], s[5 * 33]); o.w = pk(s[6 * 33], s[7 * 33]);
        *(u32x4*)(WT + (size_t)(dst_n0 + n) * K + k0 + 8 * c) = o; }
    asm volatile("s_waitcnt lgkmcnt(0)" ::: "memory");
}
template <bool OUT_BF16>
__device__ __forceinline__ void ln_row(const float* xr_, const float* g, const float* b, void* orow, int lane) {
    const f32x4* xr = (const f32x4*)xr_ + lane;
    f32x4 v[4]; float s = 0.f;
#pragma unroll
    for (int j = 0; j < 4; ++j) { v[j] = xr[64 * j]; s += (v[j].x + v[j].y) + (v[j].z + v[j].w); }
    const float mean = wave_sum(s) * (1.f / DM); float s2 = 0.f;
#pragma unroll
    for (int j = 0; j < 4; ++j) { v[j] = v[j] - mean; s2 += (v[j].x * v[j].x + v[j].y * v[j].y) + (v[j].z * v[j].z + v[j].w * v[j].w); }
    const float rstd = 1.f / sqrtf(wave_sum(s2) * (1.f / DM) + LN_EPS);
#pragma unroll
    for (int j = 0; j < 4; ++j) { const f32x4 gg = *((const f32x4*)g + lane + 64 * j), bb = *((const f32x4*)b + lane + 64 * j);
        const f32x4 o = v[j] * rstd * gg + bb;
        if (OUT_BF16) { u32x2 w; w.x = pk(o[0], o[1]); w.y = pk(o[2], o[3]); *((u32x2*)orow + lane + 64 * j) = w; }
        else *((f32x4*)orow + lane + 64 * j) = o; }
}
__device__ __forceinline__ void p0_prologue(Frame& F) {
    LAS float* scr = (LAS float*)(F.lds + F.wave * 16384);
    const int gw = F.bid * NWAVES + F.wave, NGW = F.G * NWAVES;
    bf16* WIN = (bf16*)(F.ws + WS_WIN); bf16* WOUT = (bf16*)(F.ws + WS_WOUT); bf16* WUP = (bf16*)(F.ws + WS_WUP); bf16* WDN = (bf16*)(F.ws + WS_WDN);
    constexpr int I_IN = 16 * (NIN / 32), I_OUT = 16 * 32, I_UP = 16 * (FF2 / 32), I_DN = (FF / 64) * 32;
    for (int it = gw; it < I_IN + I_OUT + I_UP + I_DN; it += NGW) {
        int r = it;
        if (r < I_IN) { const int nb = r % (NIN / 32), kb = r / (NIN / 32), d0 = nb * 32;
            const int s0 = d0 < 1536 ? d0 : (d0 < 3072 ? d0 + 32 : (d0 < 3104 ? 1536 : -1));
            p0_transpose_item(F.in[4], DM, 3104, s0, WIN, d0, kb * 64, scr, F.lane); continue; } r -= I_IN;
        if (r < I_OUT) { const int nb = r % 32, kb = r / 32; p0_transpose_item(F.in[11], DM, DM, nb * 32, WOUT, nb * 32, kb * 64, scr, F.lane); continue; } r -= I_OUT;
        if (r < I_UP) { const int nb = r % (FF2 / 32), kb = r / (FF2 / 32), d0 = nb * 32, pn = d0 >> 8, wi = d0 & 255;
            const int s0 = pn * 128 + (wi & 127) + (wi >> 7) * FF;
            p0_transpose_item(F.in[14], DM, FF2, s0, WUP, d0, kb * 64, scr, F.lane); continue; } r -= I_UP;
        { const int nb = r % 32, kb = r / 32; p0_transpose_item(F.in[17], FF, DM, nb * 32, WDN, nb * 32, kb * 64, scr, F.lane); }
    }
    bf16* XN = (bf16*)(F.ws + WS_XN);
    for (int m = gw; m < T; m += NGW) ln_row<true>(xrow(F, m), F.in[2], F.in[3], XN + (size_t)m * DM, F.lane);
}

__device__ __forceinline__ float logsig16(float z) { return -(fmaxf(-z, 0.f) + __logf(1.f + __expf(-fabsf(z)))) * (1.f / 16.f); }
__device__ __forceinline__ void gla_gates(const Frame& F, int gc, LAS float* LRS, LAS float* WT, const float (&wf)[16], const float (&wb)[16], float bf_, float bb_,
                                          float (&laf)[8], float (&lab)[8], float (&Pf)[8], float (&Pb)[8], float& totf, float& totb) {
    const float* LR = (const float*)(F.ws + WS_LR);
    const int w = F.wave, lane = F.lane;
    *(LAS f32x4*)(LRS + F.tid * 4) = *(const f32x4*)(LR + (size_t)gc * 2048 + F.tid * 4);
    __syncthreads();
    float sf = 0.f, sb = 0.f;
#pragma unroll
    for (int t = 0; t < 8; ++t) {
        const LAS float* lr = LRS + (8 * w + t) * 32;
        float zf = bf_, zb = bb_;
#pragma unroll
        for (int q = 0; q < 4; ++q) { const f32x4 a = *(const LAS f32x4*)(lr + 4 * q), b = *(const LAS f32x4*)(lr + 16 + 4 * q);
            zf += a[0] * wf[4 * q] + a[1] * wf[4 * q + 1] + a[2] * wf[4 * q + 2] + a[3] * wf[4 * q + 3];
            zb += b[0] * wb[4 * q] + b[1] * wb[4 * q + 1] + b[2] * wb[4 * q + 2] + b[3] * wb[4 * q + 3]; }
        const float lf = logsig16(zf), lb = logsig16(zb);
        laf[t] = lf; lab[t] = lb; sf += lf; sb += lb; Pf[t] = sf; Pb[t] = sb;
    }
    WT[w * 64 + lane] = sf; WT[(8 + w) * 64 + lane] = sb;
    __syncthreads();
    float of = 0.f, ob = 0.f, tf = 0.f, tb = 0.f;
#pragma unroll
    for (int x = 0; x < 8; ++x) { const float vf = WT[x * 64 + lane], vb = WT[(8 + x) * 64 + lane]; tf += vf; tb += vb; if (x < w) { of += vf; ob += vb; } }
#pragma unroll
    for (int t = 0; t < 8; ++t) { Pf[t] += of; Pb[t] += ob; }
    totf = tf; totb = tb;
}

__device__ __forceinline__ void na_unit(const Frame& F, int gc, int head, int cb, const LAS float* rpb) {
    const bf16* NQ = (const bf16*)(F.ws + WS_NQ); const bf16* NK = (const bf16*)(F.ws + WS_NK); const bf16* NVT = (const bf16*)(F.ws + WS_NVT);
    bf16* MIX = (bf16*)((unsigned char*)F.out + OUT_MIX);
    const int lane = F.lane, fr = lane & 15, fq = lane >> 4;
    const int sb = gc < 512 ? (gc & ~63) : 512, rows = gc < 512 ? 64 : 256, r = gc - sb;
    int rs = r - 4; rs = rs < 0 ? 0 : (rs > rows - 8 ? rows - 8 : rs);
    int bs = 16 * cb - 8; bs = bs < 0 ? 0 : (bs > 32 ? 32 : bs);
    const int qc = 16 * cb + fr; int qcs = qc - 8; qcs = qcs < 0 ? 0 : (qcs > 48 ? 48 : qcs);
    const bf16* qp = NQ + (size_t)(gc * 64 + qc) * 512 + head * 64 + 16 * fq;
    const bf16x8 q0 = *(const bf16x8*)qp, q1 = *(const bf16x8*)(qp + 8);
    const int pr = 8 * (fr >> 2) + (fr & 3);
    f32x4 S[16];
#pragma unroll
    for (int hf = 0; hf < 2; ++hf) {
        bf16x8 kf[8][2];
#pragma unroll
        for (int t = 0; t < 8; ++t) { const int kt = 8 * hf + t;
            const bf16* kp = NK + (size_t)((sb + rs + (kt >> 1)) * 64 + bs + pr + 4 * (kt & 1)) * 512 + head * 64 + 16 * fq;
            kf[t][0] = *(const bf16x8*)kp; kf[t][1] = *(const bf16x8*)(kp + 8); }
        __builtin_amdgcn_sched_barrier(0);
#pragma unroll
        for (int t = 0; t < 8; ++t) { f32x4 a = {0.f, 0.f, 0.f, 0.f};
            a = __builtin_amdgcn_mfma_f32_16x16x32_bf16(kf[t][0], q0, a, 0, 0, 0);
            a = __builtin_amdgcn_mfma_f32_16x16x32_bf16(kf[t][1], q1, a, 0, 0, 0);
            S[8 * hf + t] = a; }
        __builtin_amdgcn_sched_barrier(0);
    }
    float mx = -1e30f;
#pragma unroll
    for (int kt = 0; kt < 16; ++kt) {
        const int dr = rs + (kt >> 1) - r;
#pragma unroll
        for (int i = 0; i < 4; ++i) {
            const int kc = bs + 8 * fq + 4 * (kt & 1) + i;
            int dc = kc - qc; dc = dc < -15 ? -15 : (dc > 15 ? 15 : dc);
            const bool ok = (kc >= qcs) && (kc < qcs + 16);
            const float bias = rpb[(dr + 7) * 31 + dc + 15];
            const float s = ok ? S[kt][i] + bias : -1e30f;
            S[kt][i] = s; mx = fmaxf(mx, s);
        }
    }
    mx = fmaxf(mx, __shfl_xor(mx, 16)); mx = fmaxf(mx, __shfl_xor(mx, 32));
    float sum = 0.f;
#pragma unroll
    for (int kt = 0; kt < 16; ++kt)
#pragma unroll
        for (int i = 0; i < 4; ++i) { const float p = __expf(S[kt][i] - mx); S[kt][i] = p; sum += p; }
    sum += __shfl_xor(sum, 16); sum += __shfl_xor(sum, 32);
    const float inv = 1.f / sum;
    unsigned pw[8][4];
#pragma unroll
    for (int kk = 0; kk < 8; ++kk) { pw[kk][0] = pk(S[2 * kk][0], S[2 * kk][1]); pw[kk][1] = pk(S[2 * kk][2], S[2 * kk][3]); pw[kk][2] = pk(S[2 * kk + 1][0], S[2 * kk + 1][1]); pw[kk][3] = pk(S[2 * kk + 1][2], S[2 * kk + 1][3]); }
    f32x4 O[4];
#pragma unroll
    for (int df = 0; df < 4; ++df) O[df] = (f32x4){0.f, 0.f, 0.f, 0.f};
#pragma unroll
    for (int hf = 0; hf < 2; ++hf) {
        bf16x8 vf[4][4];
#pragma unroll
        for (int t = 0; t < 4; ++t)
#pragma unroll
            for (int df = 0; df < 4; ++df)
                vf[t][df] = *(const bf16x8*)(NVT + (size_t)(head * 64 + 16 * df + fr) * T + (size_t)(sb + rs + 4 * hf + t) * 64 + bs + 8 * fq);
        __builtin_amdgcn_sched_barrier(0);
#pragma unroll
        for (int t = 0; t < 4; ++t) { const int kk = 4 * hf + t; const u32x4 pv = {pw[kk][0], pw[kk][1], pw[kk][2], pw[kk][3]};
#pragma unroll
            for (int df = 0; df < 4; ++df) O[df] = __builtin_amdgcn_mfma_f32_16x16x32_bf16(vf[t][df], __builtin_bit_cast(bf16x8, pv), O[df], 0, 0, 0); }
        __builtin_amdgcn_sched_barrier(0);
    }
    bf16* op = MIX + (size_t)(gc * 64 + qc) * DM + 512 + head * 64 + 4 * fq;
#pragma unroll
    for (int df = 0; df < 4; ++df) { u32x2 w; w.x = pk(O[df][0] * inv, O[df][1] * inv); w.y = pk(O[df][2] * inv, O[df][3] * inv); *(u32x2*)(op + 16 * df) = w; }
}
__device__ __forceinline__ void p2_phase(Frame& F) {
    const bf16* GK = (const bf16*)(F.ws + WS_GK); const bf16* GV = (const bf16*)(F.ws + WS_GV);
    bf16* US = (bf16*)((unsigned char*)F.out + OUT_US); float* DEC = (float*)(F.ws + WS_DEC);
    LAS bf16* KE = (LAS bf16*)F.lds;
    LAS bf16* VT = (LAS bf16*)(F.lds + 18432);
    LAS float* LRS = (LAS float*)(F.lds + 36864);
    LAS float* WT = (LAS float*)(F.lds + 45056);
    LAS float* RPB = (LAS float*)(F.lds + 49152);
    const int lane = F.lane, w = F.wave, fr = lane & 15, fq = lane >> 4;
    const int h = F.bid & 3;
    if ((F.G & 3) != 0) return;
    float wf[16], wb[16];
#pragma unroll
    for (int k = 0; k < 16; ++k) { wf[k] = F.in[5][k * 256 + h * 64 + lane]; wb[k] = F.in[7][k * 256 + h * 64 + lane]; }
    const float bf_ = F.in[6][h * 64 + lane], bb_ = F.in[8][h * 64 + lane];
    for (int i = F.tid; i < 2 * 465; i += NTHR) RPB[i] = F.in[10][(2 * h) * 465 + i];
    __syncthreads();
    for (int u = F.bid; u < NCH * 4; u += F.G) {
        const int gc = u >> 2;
        {
            unsigned short kraw[8];
#pragma unroll
            for (int t = 0; t < 8; ++t) kraw[t] = GK[(size_t)(gc * 64 + 8 * w + t) * 256 + h * 64 + lane];
            const u32x4* vp = (const u32x4*)(GV + (size_t)(gc * 64 + lane) * 512 + h * 128 + 16 * w);
            const u32x4 v0 = vp[0], v1 = vp[1];
            __builtin_amdgcn_sched_barrier(0);
            float laf[8], lab[8], Pf[8], Pb[8], totf, totb;
            gla_gates(F, gc, LRS, WT, wf, wb, bf_, bb_, laf, lab, Pf, Pb, totf, totb);
            float kf[8], kb[8];
#pragma unroll
            for (int t = 0; t < 8; ++t) { const float kv = bf2f(kraw[t]);
                kf[t] = kv * __expf(totf - Pf[t]); kb[t] = kv * __expf(Pb[t] - lab[t]); }
            *(LAS u32x4*)(KE + (0 * 64 + lane) * LP + 8 * w) = (u32x4){pk(kf[0], kf[1]), pk(kf[2], kf[3]), pk(kf[4], kf[5]), pk(kf[6], kf[7])};
            *(LAS u32x4*)(KE + (1 * 64 + lane) * LP + 8 * w) = (u32x4){pk(kb[0], kb[1]), pk(kb[2], kb[3]), pk(kb[4], kb[5]), pk(kb[6], kb[7])};
            if (w == 0) { DEC[(size_t)((gc * 4 + h) * 2 + 0) * 64 + lane] = __expf(totf); DEC[(size_t)((gc * 4 + h) * 2 + 1) * 64 + lane] = __expf(totb); }
            const unsigned vw[8] = {v0.x, v0.y, v0.z, v0.w, v1.x, v1.y, v1.z, v1.w};
#pragma unroll
            for (int i = 0; i < 16; ++i) VT[(16 * w + i) * LP + lane] = (bf16)((i & 1) ? (vw[i >> 1] >> 16) : (vw[i >> 1] & 0xffffu));
        }
        __syncthreads();
        {
            const int dir = w >> 2, mf = w & 3;
            bf16x8 a[2];
#pragma unroll
            for (int ks = 0; ks < 2; ++ks) a[ks] = *(const LAS bf16x8*)(KE + (dir * 64 + 16 * mf + fr) * LP + 32 * ks + 8 * fq);
            bf16* up = US + (size_t)((gc * 4 + h) * 2 + dir) * 8192 + 16 * mf + 4 * fq;
#pragma unroll
            for (int nf = 0; nf < 8; ++nf) {
                f32x4 acc = {0.f, 0.f, 0.f, 0.f};
#pragma unroll
                for (int ks = 0; ks < 2; ++ks) { const bf16x8 b = *(const LAS bf16x8*)(VT + (16 * nf + fr) * LP + 32 * ks + 8 * fq);
                    acc = __builtin_amdgcn_mfma_f32_16x16x32_bf16(a[ks], b, acc, 0, 0, 0); }
                u32x2 o; o.x = pk(acc[0], acc[1]); o.y = pk(acc[2], acc[3]);
                *(u32x2*)(up + (size_t)(16 * nf + fr) * 64) = o;
            }
        }
        na_unit(F, gc, 2 * h + (w >> 2), w & 3, RPB + (w >> 2) * 465);
        __syncthreads();
    }
}

__device__ __forceinline__ void p3_chain(bf16* US, const float* DEC, int base, int n, int h, int dir, int e0) {
    const int d0 = e0 & 63;
    float S0 = 0.f, S1 = 0.f;
    for (int c0 = 0; c0 < n; c0 += 32) {
        unsigned uu[32]; f32x2 dd[32];
#pragma unroll
        for (int s = 0; s < 32; ++s) { const int c = dir ? (n - 1 - (c0 + s)) : (c0 + s); const size_t unit = (size_t)(((base + c) * 4 + h) * 2 + dir);
            uu[s] = *(const unsigned*)(US + unit * 8192 + e0); dd[s] = *(const f32x2*)(DEC + unit * 64 + d0); }
#pragma unroll
        for (int s = 0; s < 32; ++s) { const int c = dir ? (n - 1 - (c0 + s)) : (c0 + s); const size_t unit = (size_t)(((base + c) * 4 + h) * 2 + dir);
            *(unsigned*)(US + unit * 8192 + e0) = pk(S0, S1);
            S0 = dd[s][0] * S0 + bflo(uu[s]); S1 = dd[s][1] * S1 + bfhi(uu[s]); }
    }
}
__device__ __forceinline__ void p3_phase(Frame& F) {
    bf16* US = (bf16*)((unsigned char*)F.out + OUT_US); const float* DEC = (const float*)(F.ws + WS_DEC);
    const int gwt = F.wave * F.G + F.bid, NGW = F.G * NWAVES;
    for (int task = gwt; task < 512; task += NGW) { const int chain = task >> 6, sub = task & 63; p3_chain(US, DEC, 512, 256, chain >> 1, chain & 1, sub * 128 + F.lane * 2); }
    const int nshort_w = NGW > 512 ? NGW - 512 : NGW, first = NGW > 512 ? gwt - 512 : gwt;
    if (first >= 0)
        for (int t2 = first; t2 < 4096; t2 += nshort_w) { const int cf = t2 >> 6, sub = t2 & 63, chain = cf & 7; p3_chain(US, DEC, (cf >> 3) * 64, 64, chain >> 1, chain & 1, sub * 128 + F.lane * 2); }
}

__device__ __forceinline__ void p4_phase(Frame& F) {
    const bf16* GQ = (const bf16*)(F.ws + WS_GQ); const bf16* GK = (const bf16*)(F.ws + WS_GK); const bf16* GV = (const bf16*)(F.ws + WS_GV); const bf16* GG = (const bf16*)(F.ws + WS_GG);
    const bf16* US = (const bf16*)((unsigned char*)F.out + OUT_US); bf16* MIX = (bf16*)((unsigned char*)F.out + OUT_MIX);
    const float* ng = F.in[9];
    LAS bf16* QI = (LAS bf16*)F.lds;
    LAS bf16* KI = (LAS bf16*)(F.lds + 18432);
    LAS bf16* VT = (LAS bf16*)(F.lds + 36864);
    LAS float* SS = (LAS float*)(F.lds + 55296);
    LAS float* LRS = (LAS float*)(F.lds + 55808);
    LAS float* WT = (LAS float*)(F.lds + 64000);
    const int lane = F.lane, w = F.wave, fr = lane & 15, fq = lane >> 4;
    const int h = F.bid & 3;
    if ((F.G & 3) != 0) return;
    float wf[16], wb[16];
#pragma unroll
    for (int k = 0; k < 16; ++k) { wf[k] = F.in[5][k * 256 + h * 64 + lane]; wb[k] = F.in[7][k * 256 + h * 64 + lane]; }
    const float bf_ = F.in[6][h * 64 + lane], bb_ = F.in[8][h * 64 + lane];
    for (int u = F.bid; u < NCH * 4; u += F.G) {
        const int gc = u >> 2;
        {
            unsigned short qraw[8], kraw[8];
#pragma unroll
            for (int t = 0; t < 8; ++t) { const size_t ro = (size_t)(gc * 64 + 8 * w + t) * 256 + h * 64 + lane; qraw[t] = GQ[ro]; kraw[t] = GK[ro]; }
            const u32x4* vp = (const u32x4*)(GV + (size_t)(gc * 64 + lane) * 512 + h * 128 + 16 * w);
            const u32x4 v0 = vp[0], v1 = vp[1];
            __builtin_amdgcn_sched_barrier(0);
            float laf[8], lab[8], Pf[8], Pb[8], totf, totb;
            gla_gates(F, gc, LRS, WT, wf, wb, bf_, bb_, laf, lab, Pf, Pb, totf, totb);
#pragma unroll
            for (int t = 0; t < 8; ++t) { const int j = 8 * w + t;
                const float qv = bf2f(qraw[t]), kv = bf2f(kraw[t]);
                const float b0 = Pf[t], b1 = totb - Pb[t] + lab[t];
                QI[(j) * LP + lane] = (bf16)(pk(qv * __expf(b0), 0.f) & 0xffffu); QI[(64 + j) * LP + lane] = (bf16)(pk(qv * __expf(b1), 0.f) & 0xffffu);
                KI[(j) * LP + lane] = (bf16)(pk(kv * __expf(-b0), 0.f) & 0xffffu); KI[(64 + j) * LP + lane] = (bf16)(pk(kv * __expf(-b1), 0.f) & 0xffffu); }
            const unsigned vw[8] = {v0.x, v0.y, v0.z, v0.w, v1.x, v1.y, v1.z, v1.w};
#pragma unroll
            for (int i = 0; i < 16; ++i) VT[(16 * w + i) * LP + lane] = (bf16)((i & 1) ? (vw[i >> 1] >> 16) : (vw[i >> 1] & 0xffffu));
        }
        __syncthreads();
        const int it = w & 3, vh = w >> 2, ti = 16 * it + fr;
        f32x4 O[4];
        {
            bf16x8 qf[2][2];
#pragma unroll
            for (int d = 0; d < 2; ++d)
#pragma unroll
                for (int ks = 0; ks < 2; ++ks) qf[d][ks] = *(const LAS bf16x8*)(QI + (d * 64 + ti) * LP + 32 * ks + 8 * fq);
            unsigned at[4][2];
#pragma unroll
            for (int jt = 0; jt < 4; ++jt) {
                f32x4 af = {0.f, 0.f, 0.f, 0.f}, ab = {0.f, 0.f, 0.f, 0.f};
#pragma unroll
                for (int ks = 0; ks < 2; ++ks) {
                    const bf16x8 kf = *(const LAS bf16x8*)(KI + (0 * 64 + 16 * jt + fr) * LP + 32 * ks + 8 * fq);
                    const bf16x8 kb = *(const LAS bf16x8*)(KI + (1 * 64 + 16 * jt + fr) * LP + 32 * ks + 8 * fq);
                    af = __builtin_amdgcn_mfma_f32_16x16x32_bf16(kf, qf[0][ks], af, 0, 0, 0);
                    ab = __builtin_amdgcn_mfma_f32_16x16x32_bf16(kb, qf[1][ks], ab, 0, 0, 0);
                }
                float val[4];
#pragma unroll
                for (int r = 0; r < 4; ++r) { const int j = 16 * jt + 4 * fq + r; val[r] = (ti >= j ? af[r] : 0.f) + (ti <= j ? ab[r] : 0.f); }
                at[jt][0] = pk(val[0], val[1]); at[jt][1] = pk(val[2], val[3]);
            }
            const size_t ubase = (size_t)((gc * 4 + h) * 2) * 8192;
            bf16x8 sfr[4][2][2];
#pragma unroll
            for (int v = 0; v < 4; ++v)
#pragma unroll
                for (int d = 0; d < 2; ++d)
#pragma unroll
                    for (int ks = 0; ks < 2; ++ks) sfr[v][d][ks] = *(const bf16x8*)(US + ubase + (size_t)d * 8192 + (16 * (4 * vh + v) + fr) * 64 + 32 * ks + 8 * fq);
            __builtin_amdgcn_sched_barrier(0);
#pragma unroll
            for (int v = 0; v < 4; ++v) {
                const int vt = 4 * vh + v;
                f32x4 o = {0.f, 0.f, 0.f, 0.f};
#pragma unroll
                for (int kk = 0; kk < 2; ++kk) {
                    const LAS bf16* vp = VT + (16 * vt + fr) * LP + 32 * kk + 4 * fq;
                    const u32x2 a0 = *(const LAS u32x2*)vp, a1 = *(const LAS u32x2*)(vp + 16);
                    const u32x4 aw = {a0.x, a0.y, a1.x, a1.y}; const u32x4 bw = {at[2 * kk][0], at[2 * kk][1], at[2 * kk + 1][0], at[2 * kk + 1][1]};
                    o = __builtin_amdgcn_mfma_f32_16x16x32_bf16(__builtin_bit_cast(bf16x8, aw), __builtin_bit_cast(bf16x8, bw), o, 0, 0, 0);
                }
#pragma unroll
                for (int d = 0; d < 2; ++d)
#pragma unroll
                    for (int ks = 0; ks < 2; ++ks) {
                        o = __builtin_amdgcn_mfma_f32_16x16x32_bf16(sfr[v][d][ks], qf[d][ks], o, 0, 0, 0);
                    }
                O[v] = o;
            }
            float ss = 0.f;
#pragma unroll
            for (int v = 0; v < 4; ++v) ss += (O[v][0] * O[v][0] + O[v][1] * O[v][1]) + (O[v][2] * O[v][2] + O[v][3] * O[v][3]);
            ss += __shfl_xor(ss, 16); ss += __shfl_xor(ss, 32);
            if (fq == 0) SS[vh * 64 + ti] = ss;
        }
        __syncthreads();
        {
            const float rstd = 1.f / sqrtf((SS[ti] + SS[64 + ti]) * (1.f / 128.f) + RMS_EPS);
            const size_t tok = (size_t)gc * 64 + ti;
#pragma unroll
            for (int v = 0; v < 4; ++v) {
                const int vc = 16 * (4 * vh + v) + 4 * fq;
                const u32x2 gw = *(const u32x2*)(GG + tok * 512 + h * 128 + vc);
                const f32x4 gn = *(const f32x4*)(ng + vc);
                const float g0 = bflo(gw.x), g1 = bfhi(gw.x), g2 = bflo(gw.y), g3 = bfhi(gw.y);
                const float o0 = O[v][0] * rstd * gn[0] * g0 * sigmoidf_(g0), o1 = O[v][1] * rstd * gn[1] * g1 * sigmoidf_(g1);
                const float o2 = O[v][2] * rstd * gn[2] * g2 * sigmoidf_(g2), o3 = O[v][3] * rstd * gn[3] * g3 * sigmoidf_(g3);
                u32x2 ow; ow.x = pk(o0, o1); ow.y = pk(o2, o3);
                *(u32x2*)(MIX + tok * DM + h * 128 + vc) = ow;
            }
        }
        __syncthreads();
    }
}

__device__ __forceinline__ void p8_phase(Frame& F) {
    const bf16* HRAW = (const bf16*)(F.ws + WS_HRAW); bf16* ACT = (bf16*)(F.ws + WS_ACT);
    const float* cw = F.in[15]; const float* cb = F.in[16];
    const int NIT = NCH * 2 * (FF / 8);
    for (int it = F.bid * NTHR + F.tid; it < NIT; it += F.G * NTHR) {
        const int cg8 = it % (FF / 8), rw = it / (FF / 8), seg = rw >> 1, last = rw & 1, ch = cg8 * 8;
        const bool sstart = seg < 512 ? ((seg & 63) == 0) : (seg == 512), send = seg < 512 ? ((seg & 63) == 63) : (seg == NCH - 1);
        const bf16* pc = HRAW + (size_t)(seg * 4 + (last ? 3 : 0)) * FF2 + ch;
        const bf16* pp = last ? HRAW + (size_t)(seg * 4 + 2) * FF2 + ch : (sstart ? nullptr : HRAW + (size_t)((seg - 1) * 4 + 3) * FF2 + ch);
        const bf16* pn = last ? (send ? nullptr : HRAW + (size_t)((seg + 1) * 4 + 0) * FF2 + ch) : HRAW + (size_t)(seg * 4 + 1) * FF2 + ch;
        const u32x4 z4 = {0u, 0u, 0u, 0u};
        const u32x4 ca = *(const u32x4*)pc, cgt = *(const u32x4*)(pc + FF);
        const u32x4 pa = pp ? *(const u32x4*)pp : z4, pg = pp ? *(const u32x4*)(pp + FF) : z4;
        const u32x4 na = pn ? *(const u32x4*)pn : z4, ngt = pn ? *(const u32x4*)(pn + FF) : z4;
        unsigned ow[4];
#pragma unroll
        for (int p = 0; p < 4; ++p) {
            float o[2];
#pragma unroll
            for (int e = 0; e < 2; ++e) {
                const int c = ch + 2 * p + e;
                const float a = e ? bfhi(ca[p]) : bflo(ca[p]), g = e ? bfhi(cgt[p]) : bflo(cgt[p]);
                const float ap = e ? bfhi(pa[p]) : bflo(pa[p]), gp = e ? bfhi(pg[p]) : bflo(pg[p]);
                const float an = e ? bfhi(na[p]) : bflo(na[p]), gn = e ? bfhi(ngt[p]) : bflo(ngt[p]);
                const float av = cw[c] * ap + cw[FF2 + c] * a + cw[2 * FF2 + c] * an + cb[c];
                const float gv = cw[FF + c] * gp + cw[FF2 + FF + c] * g + cw[2 * FF2 + FF + c] * gn + cb[FF + c];
                o[e] = av * gv * sigmoidf_(gv);
            }
            ow[p] = pk(o[0], o[1]);
        }
        *(u32x4*)(ACT + (size_t)(seg * 64 + (last ? 63 : 0)) * FF + ch) = (u32x4){ow[0], ow[1], ow[2], ow[3]};
    }
}

#define XB_TMO      128
#define XB_XCNT(j)  (256  + 64 * (j))
#define XB_XSUB(j)  (1280 + 64 * (j))
#define XB_XGEN(j)  (2304 + 64 * (j))
#define XB_TOP      3328
#define XB_TOPGEN   3392
#define XCD_BAR_WORDS 3456
#define XB_SPIN_CAP (1u << 18)

__device__ __forceinline__ unsigned xb_ld(unsigned* p)              { return __hip_atomic_load(p, __ATOMIC_RELAXED, __HIP_MEMORY_SCOPE_AGENT); }
__device__ __forceinline__ unsigned xb_add(unsigned* p, unsigned v) { return __hip_atomic_fetch_add(p, v, __ATOMIC_RELAXED, __HIP_MEMORY_SCOPE_AGENT); }
__device__ __forceinline__ unsigned xb_xcc_id() { return (unsigned)__builtin_amdgcn_s_getreg((3 << 11) | 20) & 0xFu; }
#define XB_SPIN(cond, bar) do { unsigned _sp = 0; while (cond) { __builtin_amdgcn_s_sleep(1); \
    if ((++_sp & 255u) == 0u) { if (xb_ld(&(bar)[XB_TMO])) break; if (_sp > XB_SPIN_CAP) { atomicAdd(&(bar)[XB_TMO], 1u); break; } } } } while (0)
struct XcdBarrier {
    unsigned* bar; unsigned x;
    volatile LAS unsigned* st;
};

__device__ __forceinline__ XcdBarrier xcd_barrier_post(unsigned* bar, volatile LAS unsigned* st) {
    XcdBarrier b; b.bar = bar; b.x = xb_xcc_id(); b.st = st;
    if (threadIdx.x == 0) (void)xb_add(&bar[XB_XCNT(b.x)], 1u);
    return b;
}
__device__ __forceinline__ void xcd_barrier_complete(unsigned* bar, unsigned x, unsigned& nloc, unsigned& nx) {
    const unsigned G = gridDim.x * gridDim.y * gridDim.z;
    unsigned sum, cnt, mine, sp = 0u;
    for (;;) {
        sum = 0u; cnt = 0u; mine = 0u;
#pragma unroll
        for (unsigned j = 0; j < 16; ++j) { const unsigned c = xb_ld(&bar[XB_XCNT(j)]); sum += c; cnt += (c > 0u) ? 1u : 0u; mine = (j == x) ? c : mine; }
        if (sum == G) break;
        __builtin_amdgcn_s_sleep(1);
        if ((++sp & 255u) == 0u) { if (xb_ld(&bar[XB_TMO])) break; if (sp > XB_SPIN_CAP) { atomicAdd(&bar[XB_TMO], 1u); break; } }
    }
    nloc = mine > 0u ? mine : 1u; nx = cnt > 0u ? cnt : 1u;
}

__device__ __forceinline__ void xcd_barrier(const XcdBarrier& b) {
    asm volatile("s_waitcnt vmcnt(0)" ::: "memory");
    __syncthreads();
    if (threadIdx.x == 0) {
        unsigned* bar = b.bar;
        __builtin_amdgcn_s_waitcnt(0);
        unsigned nloc = b.st[0], nx = b.st[1];
        if (nloc == 0u) { xcd_barrier_complete(bar, b.x, nloc, nx); b.st[0] = nloc; b.st[1] = nx; }
        const unsigned old = xb_add(&bar[XB_XSUB(b.x)], 1u);
        const unsigned gen = old / nloc;
        if (old + 1u == (gen + 1u) * nloc) {
            __builtin_amdgcn_fence(__ATOMIC_RELEASE, "agent");
            asm volatile("s_waitcnt vmcnt(0)" ::: "memory");
            const unsigned og = xb_add(&bar[XB_TOP], 1u);
            const unsigned tg = og / nx;
            if (og + 1u == (tg + 1u) * nx) xb_add(&bar[XB_TOPGEN], 1u);
            else XB_SPIN(xb_ld(&bar[XB_TOPGEN]) == tg, bar);
            __builtin_amdgcn_fence(__ATOMIC_ACQUIRE, "agent");
            xb_add(&bar[XB_XGEN(b.x)], 1u);
            asm volatile("s_waitcnt vmcnt(0)" ::: "memory");
        } else {
            XB_SPIN(xb_ld(&bar[XB_XGEN(b.x)]) == gen, bar);
            __builtin_amdgcn_fence(__ATOMIC_ACQUIRE, "agent");
            asm volatile("s_waitcnt vmcnt(0)" ::: "memory");
        }
    }
    __syncthreads();
}

__global__ void __launch_bounds__(NTHR, 2) hymba_fwd(Params prm) {
    extern __shared__ __attribute__((aligned(16))) unsigned char lds_raw[];
    cg::grid_group grid = cg::this_grid();
    Frame F;
    F.lds = (LAS unsigned char*)lds_raw;
    F.tid = threadIdx.x; F.lane = F.tid & 63; F.wave = __builtin_amdgcn_readfirstlane(F.tid >> 6);
    F.G = gridDim.x; F.bid = blockIdx.x;
#pragma unroll
    for (int i = 0; i < 20; ++i) F.in[i] = prm.in[i];
    F.out = prm.out; F.ws = prm.ws;
    const int lo = prm.ph_lo, hi = prm.ph_hi;
    volatile LAS unsigned* MISC = (volatile LAS unsigned*)(F.lds + 131072 + 64);
    if (F.tid < 4) MISC[F.tid] = 0u;
    __syncthreads();
    XcdBarrier bar; bar.bar = (unsigned*)(F.ws) + 4096; bar.x = 0; bar.st = MISC;
    if (hi - lo > 1) bar = xcd_barrier_post((unsigned*)(F.ws) + 4096, MISC);
    if (lo > 1000) grid.sync();
#define IN(k) (lo <= (k) && (k) < hi)
#define SEAM(k) do { if (IN(k) && IN((k) + 1)) xcd_barrier(bar); } while (0)
    bf16* XN = (bf16*)(F.ws + WS_XN);
    bf16* MIX = (bf16*)((unsigned char*)F.out + OUT_MIX);
    if (IN(0)) { p0_prologue(F);
#if PROBE_REP == 0
        xcd_barrier(bar); { p0_prologue(F); }
#endif
    } SEAM(0);
    if (IN(1)) {
        pg8::Gemm g{XN, (const bf16*)(F.ws + WS_WIN), T, NIN, DM}; pg8::StaticOrder S; S.init(T, NIN, F.G, F.bid);
        EpiIn E{(bf16*)(F.ws + WS_GQ), (bf16*)(F.ws + WS_GK), (bf16*)(F.ws + WS_GV), (bf16*)(F.ws + WS_GG), (bf16*)(F.ws + WS_NQ), (bf16*)(F.ws + WS_NK), (bf16*)(F.ws + WS_NVT), (float*)(F.ws + WS_LR)};
        pg8::gemm_phase<EpiIn, pg8::StaticOrder, true, true>(F.lds, g, S, E);

#if PROBE_REP == 1
        xcd_barrier(bar); {
        pg8::Gemm g{XN, (const bf16*)(F.ws + WS_WIN), T, NIN, DM}; pg8::StaticOrder S; S.init(T, NIN, F.G, F.bid);
        EpiIn E{(bf16*)(F.ws + WS_GQ), (bf16*)(F.ws + WS_GK), (bf16*)(F.ws + WS_GV), (bf16*)(F.ws + WS_GG), (bf16*)(F.ws + WS_NQ), (bf16*)(F.ws + WS_NK), (bf16*)(F.ws + WS_NVT), (float*)(F.ws + WS_LR)};
        pg8::gemm_phase<EpiIn, pg8::StaticOrder, true, true>(F.lds, g, S, E);
    }
#endif
    } SEAM(1);
    if (IN(2)) { p2_phase(F);
#if PROBE_REP == 2
        xcd_barrier(bar); p2_phase(F);
#endif
    } SEAM(2);
    if (IN(3)) { p3_phase(F); } SEAM(3);
    if (IN(4)) { p4_phase(F);
#if PROBE_REP == 4
        xcd_barrier(bar); p4_phase(F);
#endif
    } SEAM(4);
    if (IN(5)) {
        pg8::Gemm g{MIX, (const bf16*)(F.ws + WS_WOUT), T, DM, DM}; pg8::StaticOrder S; S.init(T, DM, F.G, F.bid);
        EpiRes E{XN, (float*)(F.ws + WS_Y1)};
        pg8::gemm_phase<EpiRes, pg8::StaticOrder, true, true>(F.lds, g, S, E);

#if PROBE_REP == 5
        xcd_barrier(bar); {
        pg8::Gemm g{MIX, (const bf16*)(F.ws + WS_WOUT), T, DM, DM}; pg8::StaticOrder S; S.init(T, DM, F.G, F.bid);
        EpiRes E{XN, (float*)(F.ws + WS_Y1)};
        pg8::gemm_phase<EpiRes, pg8::StaticOrder, true, true>(F.lds, g, S, E);
    }
#endif
    } SEAM(5);
    if (IN(6)) {
        const int gw = F.bid * NWAVES + F.wave, NGW = F.G * NWAVES; const float* Y1 = (const float*)(F.ws + WS_Y1);
        for (int m = gw; m < T; m += NGW) ln_row<true>(Y1 + (size_t)m * DM, F.in[12], F.in[13], XN + (size_t)m * DM, F.lane);

#if PROBE_REP == 6
        xcd_barrier(bar); {
        const int gw = F.bid * NWAVES + F.wave, NGW = F.G * NWAVES; const float* Y1 = (const float*)(F.ws + WS_Y1);
        for (int m = gw; m < T; m += NGW) ln_row<true>(Y1 + (size_t)m * DM, F.in[12], F.in[13], XN + (size_t)m * DM, F.lane);
    }
#endif
    } SEAM(6);
    if (IN(7)) {
        pg8::Gemm g{XN, (const bf16*)(F.ws + WS_WUP), T, FF2, DM}; pg8::StaticOrder S; S.init(T, FF2, F.G, F.bid);
        EpiUp E{F.in[15], F.in[16], (bf16*)(F.ws + WS_ACT), (bf16*)(F.ws + WS_HRAW)};
        pg8::gemm_phase<EpiUp, pg8::StaticOrder, true, true>(F.lds, g, S, E);

#if PROBE_REP == 7
        xcd_barrier(bar); {
        pg8::Gemm g{XN, (const bf16*)(F.ws + WS_WUP), T, FF2, DM}; pg8::StaticOrder S; S.init(T, FF2, F.G, F.bid);
        EpiUp E{F.in[15], F.in[16], (bf16*)(F.ws + WS_ACT), (bf16*)(F.ws + WS_HRAW)};
        pg8::gemm_phase<EpiUp, pg8::StaticOrder, true, true>(F.lds, g, S, E);
    }
#endif
    } SEAM(7);
    if (IN(8)) { p8_phase(F);
#if PROBE_REP == 8
        xcd_barrier(bar); { p8_phase(F); }
#endif
    } SEAM(8);
    if (IN(9)) {
        pg8::Gemm g{(const bf16*)(F.ws + WS_ACT), (const bf16*)(F.ws + WS_WDN), T, DM, FF}; pg8::StaticOrder S; S.init(T, DM, F.G, F.bid);
        EpiRes E{XN, F.out};
        pg8::gemm_phase<EpiRes, pg8::StaticOrder, true, true>(F.lds, g, S, E);

#if PROBE_REP == 9
        xcd_barrier(bar); {
        pg8::Gemm g{(const bf16*)(F.ws + WS_ACT), (const bf16*)(F.ws + WS_WDN), T, DM, FF}; pg8::StaticOrder S; S.init(T, DM, F.G, F.bid);
        EpiRes E{XN, F.out};
        pg8::gemm_phase<EpiRes, pg8::StaticOrder, true, true>(F.lds, g, S, E);
    }
#endif
    } SEAM(9);
#if PROBE_REP == 100
    for (int q = 0; q < 10; ++q) xcd_barrier(bar);
#endif
    if (IN(10)) {
        const int gw = F.bid * NWAVES + F.wave, NGW = F.G * NWAVES;
        for (int m = gw; m < T; m += NGW) ln_row<false>(F.out + (size_t)m * DM, F.in[18], F.in[19], F.out + (size_t)m * DM, F.lane);
    }
#if DBG_STOP < 11
    if (IN(11)) {
        const u32x4* src = (const u32x4*)((const unsigned char*)F.out + (DBG_STOP == 5 ? OUT_MIX : OUT_US)); u32x4* dst = (u32x4*)(F.ws + WS_C);
        for (size_t i = (size_t)F.bid * NTHR + F.tid; i < (size_t)T * DM / 8; i += (size_t)F.G * NTHR) dst[i] = src[i];
    }
    if (IN(12)) {
        const bf16* src = (const bf16*)(F.ws + WS_C);
        for (size_t i = (size_t)F.bid * NTHR + F.tid; i < (size_t)T * DM; i += (size_t)F.G * NTHR) F.out[i] = bf2f(src[i]);
    }
#endif
#undef IN
#undef SEAM
}

constexpr int N_PHASES = 11;
extern "C" void kernel_launch(void* const* d_in, const int* in_sizes, int n_in, void* d_out, int out_size, void* d_ws, size_t ws_size, hipStream_t stream) {
    static int grid = 0;
    if (grid == 0) {
        if (n_in != 20 || out_size != T * DM || ws_size < WS_END) { fprintf(stderr, "kernel_launch: unexpected shapes (n_in %d out %d ws %zu)\n", n_in, out_size, ws_size); grid = -1; return; }
        int dev = 0, cus = 0, per_cu = 0;
        hipGetDevice(&dev); hipDeviceGetAttribute(&cus, hipDeviceAttributeMultiprocessorCount, dev);
        if (hipFuncSetAttribute((const void*)hymba_fwd, hipFuncAttributeMaxDynamicSharedMemorySize, LDS_BYTES) != hipSuccess) { fprintf(stderr, "kernel_launch: hipFuncSetAttribute failed\n"); grid = -1; return; }
        if (hipOccupancyMaxActiveBlocksPerMultiprocessor(&per_cu, (const void*)hymba_fwd, NTHR, LDS_BYTES) != hipSuccess || per_cu < 1) { fprintf(stderr, "kernel_launch: occupancy query says %d\n", per_cu); per_cu = 1; }
        (void)hipGetLastError();
        grid = cus * 1;
    }
    if (grid < 0) return;
    Params p{};
    for (int i = 0; i < 20; ++i) p.in[i] = (const float*)d_in[i];
    p.out = (float*)d_out; p.ws = (unsigned char*)d_ws;
#if MK_N_LAUNCHES == 1
    if (hipMemsetAsync(d_ws, 0, 65536, stream) != hipSuccess) { fprintf(stderr, "kernel_launch: memset failed\n"); return; }
    p.ph_lo = 0; p.ph_hi = N_PHASES;
    void* args[] = {&p};
    hipError_t e = hipLaunchCooperativeKernel((const void*)hymba_fwd, dim3(grid), dim3(NTHR), args, LDS_BYTES, stream);
    if (e != hipSuccess) fprintf(stderr, "cooperative launch failed: %s (grid %d)\n", hipGetErrorString(e), grid);
#else
    for (int k = 0; k < 13; ++k) { if (k >= DBG_STOP && k < 11) continue; if (k >= 11 && DBG_STOP >= 11) continue; p.ph_lo = k; p.ph_hi = k + 1; hipLaunchKernelGGL(hymba_fwd, dim3(grid), dim3(NTHR), LDS_BYTES, stream, p); }
#endif
}
```
